# Optimizing an MI355X kernel written in HIP

```python
import jax, jax.numpy as jnp
from jax import lax
import numpy as np

D_MODEL = 1024
BATCH = 2
SEQ = 8192
DEPTH = 4
DEC_BATCH = 32
DEC_SEQ = 4
PAST_LEN = 8192
PAGE_SIZE = 128

HEAD_DIM = 64
A_W = D_MODEL // 4
B_W = D_MODEL // 2
C_W = D_MODEL // 4
A_HEADS = A_W // HEAD_DIM
B_HEADS = B_W // HEAD_DIM
C_HEADS = C_W // HEAD_DIM
MIX_W = A_W + B_W + C_W
N_KV = 2
KV_W = N_KV * HEAD_DIM
IDX_HEADS = 8
IDX_DIM = 64
TOPK_MAX = 256
ROT_DIM = HEAD_DIM // 4
ROPE_THETA = 500000.0
CONV_W = 3
CHUNK = 128
D_FF = 2816
Q_BLOCK = 128
LN_EPS = 1e-5
ALPHA = (2 * DEPTH) ** 0.25
BETA = (8 * DEPTH) ** -0.25
IN_SIZES = (A_W, A_W, A_W, B_W, KV_W, KV_W, IDX_HEADS * IDX_DIM, IDX_DIM, IDX_HEADS, C_W, C_W)
N_IN = sum(IN_SIZES)

kernel_name = "hybrid_conv_dsa_gmlp_decoder_step"

F32 = jnp.float32


def _layer_norm(x, g, b):
    xf = x.astype(F32)
    mu = jnp.mean(xf, axis=-1, keepdims=True)
    xc = xf - mu
    var = jnp.mean(xc * xc, axis=-1, keepdims=True)
    return (xc * lax.rsqrt(var + LN_EPS) * g.astype(F32) + b.astype(F32)).astype(x.dtype)


def _rotary(x, pos):
    half = ROT_DIM // 2
    inv = ROPE_THETA ** (-jnp.arange(half, dtype=F32) / half)
    ang = pos.astype(F32)[:, None] * inv[None, :]
    cos = jnp.cos(ang)[:, None, :]
    sin = jnp.sin(ang)[:, None, :]
    xr = x[..., :ROT_DIM].astype(F32)
    x1, x2 = xr[..., :half], xr[..., half:]
    rot = jnp.concatenate([x1 * cos - x2 * sin, x2 * cos + x1 * sin], axis=-1)
    return jnp.concatenate([rot.astype(x.dtype), x[..., ROT_DIM:]], axis=-1)


def _causal_dwconv(z, prev, w):
    T = z.shape[1]
    zz = jnp.concatenate([prev.astype(z.dtype), z], axis=1)
    y = zz[:, 0:T] * w[0]
    for i in range(1, CONV_W):
        y = y + zz[:, i:i + T] * w[i]
    return y, zz[:, -(CONV_W - 1):]


def _project(x, pos, w):
    h = x @ w
    offs = np.cumsum(IN_SIZES)[:-1].tolist()
    gb, gc, ha, q, k, v, qi, ki, wi, u, vc = jnp.split(h, offs, axis=-1)
    Bx, T = x.shape[:2]
    q = _rotary(q.reshape(Bx, T, B_HEADS, HEAD_DIM), pos)
    k = _rotary(k.reshape(Bx, T, N_KV, HEAD_DIM), pos)
    v = v.reshape(Bx, T, N_KV, HEAD_DIM)
    qi = _rotary(qi.reshape(Bx, T, IDX_HEADS, IDX_DIM), pos)
    ki = _rotary(ki.reshape(Bx, T, 1, IDX_DIM), pos)[:, :, 0]
    wi = wi * (IDX_HEADS ** -0.5)
    return gb, gc, ha, q, k, v, qi, ki, wi, u, vc


def _short_conv(gb, gc, ha, prev, w):
    y, new_prev = _causal_dwconv(gc * ha, prev, w)
    return gb * y, new_prev


def _index_scores(qi, wi, ki):
    dots = jnp.einsum('bqhd,bsd->bqhs', qi.astype(F32), ki.astype(F32)) * (IDX_DIM ** -0.5)
    return jnp.einsum('bqhs,bqh->bqs', jax.nn.relu(dots), wi.astype(F32))


def _attend(q, kg, vg, valid):
    Bq, Q = q.shape[:2]
    qg = q.reshape(Bq, Q, N_KV, B_HEADS // N_KV, HEAD_DIM).astype(F32)
    s = jnp.einsum('bqgrd,bqkgd->bqgrk', qg, kg.astype(F32)) * (HEAD_DIM ** -0.5)
    s = jnp.where(valid[:, :, None, None, :], s, -jnp.inf)
    p = jax.nn.softmax(s, axis=-1)
    o = jnp.einsum('bqgrk,bqkgd->bqgrd', p, vg.astype(F32))
    return o.reshape(Bq, Q, B_W).astype(q.dtype)


def _gather_rows(a, idx):
    return jax.vmap(lambda aa, ii: aa[ii])(a, idx)


def _dsa_prompt(q, k, v, qi, wi, ki):
    Bp, S = q.shape[:2]
    ksel = min(TOPK_MAX, S // 4)
    nblk = S // Q_BLOCK
    spos = jnp.arange(S, dtype=jnp.int32)

    def to_blocks(a):
        return jnp.moveaxis(a.reshape(Bp, nblk, Q_BLOCK, *a.shape[2:]), 1, 0)

    def one_block(args):
        qb, qib, wib, t0 = args
        tpos = t0 + jnp.arange(Q_BLOCK, dtype=jnp.int32)
        sc = _index_scores(qib, wib, ki)
        sc = jnp.where(spos[None, None, :] <= tpos[None, :, None], sc, -jnp.inf)
        _, idx = lax.top_k(sc, ksel)
        valid = idx <= tpos[None, :, None]
        return _attend(qb, _gather_rows(k, idx), _gather_rows(v, idx), valid)

    t0s = jnp.arange(nblk, dtype=jnp.int32) * Q_BLOCK
    out = lax.map(one_block, (to_blocks(q), to_blocks(qi), to_blocks(wi), t0s))
    return jnp.moveaxis(out, 0, 1).reshape(Bp, S, B_W)


def _dsa_sample(q, k_new, v_new, qi, wi, ki_new, pool_k, pool_v, pool_ki, page_table):
    Bd, T = q.shape[:2]
    n_pages = page_table.shape[1]
    past = n_pages * PAGE_SIZE
    L = past + T
    ksel = min(TOPK_MAX, L // 4)
    ki_past = pool_ki[page_table].reshape(Bd, past, IDX_DIM)
    ki_all = jnp.concatenate([ki_past.astype(ki_new.dtype), ki_new], axis=1)
    tpos = past + jnp.arange(T, dtype=jnp.int32)
    sc = _index_scores(qi, wi, ki_all)
    sc = jnp.where(jnp.arange(L, dtype=jnp.int32)[None, None, :] <= tpos[None, :, None], sc, -jnp.inf)
    _, idx = lax.top_k(sc, ksel)
    valid = idx <= tpos[None, :, None]
    in_past = (idx < past)[..., None, None]
    page = jnp.minimum(idx // PAGE_SIZE, n_pages - 1)
    phys = jax.vmap(lambda pt, pg: pt[pg])(page_table, page)
    off = idx % PAGE_SIZE
    new_i = jnp.clip(idx - past, 0, T - 1)
    kg = jnp.where(in_past, pool_k[phys, off].astype(k_new.dtype), _gather_rows(k_new, new_i))
    vg = jnp.where(in_past, pool_v[phys, off].astype(v_new.dtype), _gather_rows(v_new, new_i))
    return _attend(q, kg, vg, valid)


def _chunk_mlp(u, vc, g, b, ws, bs):
    vn = _layer_norm(vc, g, b)
    Bx, T = u.shape[:2]
    n = min(T, CHUNK)
    mask = jnp.tril(jnp.ones((n, n), dtype=bool))
    wm = jnp.where(mask[None], ws[:, :n, :n], 0)
    vr = vn.reshape(Bx, T // n, n, C_HEADS, HEAD_DIM)
    mixed = jnp.einsum('hts,bcshd->bcthd', wm, vr) + jnp.transpose(bs[:, :n])[None, None, :, :, None]
    return u * mixed.reshape(Bx, T, C_W), vn


def _conv_ffn(x, prev, w_up, w_conv, w_down):
    h, new_prev = _causal_dwconv(x @ w_up, prev, w_conv)
    g, u = jnp.split(h, 2, axis=-1)
    return (jax.nn.silu(g) * u) @ w_down, new_prev


def setup_inputs(seed: int = 0) -> dict:
    key = jax.random.key(seed)
    ks = jax.random.split(key, 24)
    n_pages = PAST_LEN // PAGE_SIZE
    n_pool = (DEC_BATCH * n_pages * 5) // 4
    nrm = jax.random.normal
    page_table = jax.random.permutation(ks[0], n_pool)[:DEC_BATCH * n_pages].reshape(DEC_BATCH, n_pages).astype(jnp.int32)
    return {
        "x_prompt": nrm(ks[1], (BATCH, SEQ, D_MODEL), F32),
        "x_sample": nrm(ks[2], (DEC_BATCH, DEC_SEQ, D_MODEL), F32),
        "cache_k": nrm(ks[3], (DEPTH, n_pool, PAGE_SIZE, N_KV, HEAD_DIM), F32),
        "cache_v": nrm(ks[4], (DEPTH, n_pool, PAGE_SIZE, N_KV, HEAD_DIM), F32),
        "cache_kidx": nrm(ks[5], (DEPTH, n_pool, PAGE_SIZE, IDX_DIM), F32),
        "page_table": page_table,
        "state_conv": nrm(ks[6], (DEPTH, DEC_BATCH, CONV_W - 1, A_W), F32),
        "state_ffn_conv": nrm(ks[7], (DEPTH, DEC_BATCH, CONV_W - 1, 2 * D_FF), F32),
        "w_in": nrm(ks[8], (DEPTH, D_MODEL, N_IN), F32) * D_MODEL ** -0.5,
        "conv_a": nrm(ks[9], (DEPTH, CONV_W, A_W), F32) * 0.5,
        "ln_cv_g": 1.0 + 0.02 * nrm(ks[10], (DEPTH, C_W), F32),
        "ln_cv_b": 0.02 * nrm(ks[11], (DEPTH, C_W), F32),
        "w_sp": nrm(ks[12], (DEPTH, C_HEADS, CHUNK, CHUNK), F32) * CHUNK ** -0.5,
        "b_sp": 1.0 + 0.02 * nrm(ks[13], (DEPTH, C_HEADS, CHUNK), F32),
        "w_o": nrm(ks[14], (DEPTH, MIX_W, D_MODEL), F32) * (MIX_W ** -0.5) * BETA,
        "ln1_g": 1.0 + 0.02 * nrm(ks[15], (DEPTH, D_MODEL), F32),
        "ln1_b": 0.02 * nrm(ks[16], (DEPTH, D_MODEL), F32),
        "w_up": nrm(ks[17], (DEPTH, D_MODEL, 2 * D_FF), F32) * D_MODEL ** -0.5,
        "conv_f": nrm(ks[18], (DEPTH, CONV_W, 2 * D_FF), F32) * 0.5,
        "w_down": nrm(ks[19], (DEPTH, D_FF, D_MODEL), F32) * (D_FF ** -0.5) * BETA,
        "ln2_g": 1.0 + 0.02 * nrm(ks[20], (DEPTH, D_MODEL), F32),
        "ln2_b": 0.02 * nrm(ks[21], (DEPTH, D_MODEL), F32),
    }


def reference(x_prompt, x_sample, cache_k, cache_v, cache_kidx, page_table, state_conv, state_ffn_conv,
              w_in, conv_a, ln_cv_g, ln_cv_b, w_sp, b_sp, w_o, ln1_g, ln1_b, w_up, conv_f, w_down, ln2_g, ln2_b):
    Bp, Sp = x_prompt.shape[:2]
    Bd, Td = x_sample.shape[:2]
    past = page_table.shape[1] * PAGE_SIZE
    pos_p = jnp.arange(Sp, dtype=jnp.int32)
    pos_s = past + jnp.arange(Td, dtype=jnp.int32)
    hp, hs = x_prompt, x_sample
    kp_l, ks_l, vp_l, vs_l, kip_l, kis_l = [], [], [], [], [], []
    cp_l, cs_l, fp_l, fs_l, chs_l = [], [], [], [], []
    for l in range(DEPTH):
        gb, gc, ha, q, k, v, qi, ki, wi, u, vc = _project(hp, pos_p, w_in[l])
        a_out, conv_new = _short_conv(gb, gc, ha, jnp.zeros((Bp, CONV_W - 1, A_W), hp.dtype), conv_a[l])
        b_out = _dsa_prompt(q, k, v, qi, wi, ki)
        c_out, _ = _chunk_mlp(u, vc, ln_cv_g[l], ln_cv_b[l], w_sp[l], b_sp[l])
        mix = jnp.concatenate([a_out, b_out, c_out], axis=-1) @ w_o[l]
        hp = _layer_norm(ALPHA * hp + mix, ln1_g[l], ln1_b[l])
        f_out, ffn_new = _conv_ffn(hp, jnp.zeros((Bp, CONV_W - 1, 2 * D_FF), hp.dtype), w_up[l], conv_f[l], w_down[l])
        hp = _layer_norm(ALPHA * hp + f_out, ln2_g[l], ln2_b[l])
        kp_l.append(k); vp_l.append(v); kip_l.append(ki); cp_l.append(conv_new); fp_l.append(ffn_new)

        gb, gc, ha, q, k, v, qi, ki, wi, u, vc = _project(hs, pos_s, w_in[l])
        a_out, conv_new = _short_conv(gb, gc, ha, state_conv[l], conv_a[l])
        b_out = _dsa_sample(q, k, v, qi, wi, ki, cache_k[l], cache_v[l], cache_kidx[l], page_table)
        c_out, vn = _chunk_mlp(u, vc, ln_cv_g[l], ln_cv_b[l], w_sp[l], b_sp[l])
        mix = jnp.concatenate([a_out, b_out, c_out], axis=-1) @ w_o[l]
        hs = _layer_norm(ALPHA * hs + mix, ln1_g[l], ln1_b[l])
        f_out, ffn_new = _conv_ffn(hs, state_ffn_conv[l], w_up[l], conv_f[l], w_down[l])
        hs = _layer_norm(ALPHA * hs + f_out, ln2_g[l], ln2_b[l])
        ks_l.append(k); vs_l.append(v); kis_l.append(ki); cs_l.append(conv_new); fs_l.append(ffn_new); chs_l.append(vn)
    return (hp, hs,
            jnp.stack(kp_l), jnp.stack(ks_l),
            jnp.stack(vp_l), jnp.stack(vs_l),
            jnp.stack(kip_l), jnp.stack(kis_l),
            jnp.stack(cp_l), jnp.stack(cs_l),
            jnp.stack(fp_l), jnp.stack(fs_l),
            jnp.stack(chs_l))
```

```cpp
#include <hip/hip_runtime.h>
#include <cstdio>
#include <cstdint>
namespace pg8 {
#define PG8_LAS __attribute__((address_space(3)))
typedef unsigned short bf16_t;
typedef short bf16x8 __attribute__((ext_vector_type(8)));
typedef float f32x4 __attribute__((ext_vector_type(4)));
typedef unsigned u32x4 __attribute__((ext_vector_type(4)));
constexpr int BM = 256, BK = 64, HALF = 128, HTB = HALF * BK * 2  , STAGE_BYTES = 8 * HTB, NXCD = 8, WGM = 8;

__host__ __device__ __forceinline__ int lds_byte(int r, int c) { const int st = (r >> 4) * 2 + (c >> 5), rr = r & 15, cc = c & 31, ob = rr * 64 + cc * 2; return st * 1024 + (ob ^ (((ob >> 9) & 1) << 5)); }
__host__ __device__ __forceinline__ void stage_rc(int b, int& R, int& C) { const int st = b / 1024, sb = b % 1024, swz = sb ^ (((sb >> 9) & 1) << 5); R = (st >> 1) * 16 + swz / 64; C = (st & 1) * 32 + (swz % 64) / 2; }
__host__ __device__ __forceinline__ int perm32(int rho) { const int n = rho >> 4, i = rho & 15; return 8 * (i >> 2) + 4 * n + (i & 3); }

struct Unit { int pm, pn; };
struct Gemm { const bf16_t* A; const bf16_t* Bt; int M, N, K; };

struct StaticOrder {
    int nM, nN, nwg, G, c;
    __host__ __device__ void init(int M, int N, int G_, int c_) { nM = M / BM; nN = N / BM; nwg = nM * nN; G = G_; c = c_; }
    __host__ __device__ bool next(int i, Unit& u) const {
        const long L = (long)i * G + c; if (L >= nwg) return false;
        int wgid = (int)L; { const int q = nwg / NXCD, r = nwg % NXCD, xcd = wgid % NXCD, off = wgid / NXCD; wgid = (xcd < r ? xcd * (q + 1) : r * (q + 1) + (xcd - r) * q) + off; }
        const int nig = WGM * nN, gid = wgid / nig, fm = gid * WGM, gsz = (nM - fm) < WGM ? (nM - fm) : WGM;
        u.pm = fm + ((wgid % nig) % gsz); u.pn = (wgid % nig) / gsz; return true;
    }
    __device__ __forceinline__ void a_ready(const Unit&) const {}
    __device__ __forceinline__ void done(const Unit&) const {}
};

__device__ __forceinline__ unsigned cvt_pk_bf16(float lo, float hi) { unsigned r; asm volatile("v_cvt_pk_bf16_f32 %0, %1, %2" : "=v"(r) : "v"(lo), "v"(hi)); return r; }
typedef float f32x2 __attribute__((ext_vector_type(2)));

struct EpiInProj {
    static constexpr bool PERM = true, AFTER_DRAIN = false;
    bf16_t* H; float* WI; float* out; const float* rope; int layer;
    size_t off_kp, off_ks, off_vp, off_vs, off_kip, off_kis;
    __device__ __forceinline__ void operator()(const f32x4 (&acc)[2][2][4][2], const Unit& u, int wr, int wc, int fr, int fq) const {
        const int pn = u.pn;
        const bool rot_tile = (pn >= 3 && pn <= 8);
#pragma unroll
        for (int ai = 0; ai < 2; ++ai)
#pragma unroll
            for (int m = 0; m < 4; ++m) {
                const int row = u.pm * BM + ai * HALF + wr * 64 + m * 16 + fr;
                const int pos = row < 16384 ? (row & 8191) : (8192 + ((row - 16384) & 3));
                const bool rowok = row < 16512;
#pragma unroll
                for (int bj = 0; bj < 2; ++bj) {
                    f32x4 v0 = acc[ai][bj][m][0], v1 = acc[ai][bj][m][1];
                    const int colt = bj * HALF + wc * 32 + fq * 8;
                    const bool dorot = rot_tile && ((wc & 1) == 0) && !(pn == 5 && bj == 1) && !(pn == 8 && (bj == 1 || wc >= 2));
                    if (dorot) {
                        f32x4 p0, p1;
#pragma unroll
                        for (int e = 0; e < 4; ++e) { p0[e] = __shfl_xor(v0[e], 16); p1[e] = __shfl_xor(v1[e], 16); }
                        if (fq < 2) {
                            const f32x4 c0 = *(const f32x4*)(rope + (size_t)pos * 16), c1 = *(const f32x4*)(rope + (size_t)pos * 16 + 4);
                            f32x4 s0 = *(const f32x4*)(rope + (size_t)pos * 16 + 8), s1 = *(const f32x4*)(rope + (size_t)pos * 16 + 12);
                            if (fq == 0) { s0 = -s0; s1 = -s1; }
                            v0 = v0 * c0 + p0 * s0; v1 = v1 * c1 + p1 * s1;
                        }
                    }
                    u32x4 w; w.x = cvt_pk_bf16(v0[0], v0[1]); w.y = cvt_pk_bf16(v0[2], v0[3]); w.z = cvt_pk_bf16(v1[0], v1[1]); w.w = cvt_pk_bf16(v1[2], v1[3]);
                    *(u32x4*)(H + (size_t)row * 2816 + pn * BM + colt) = w;
                    if (pn == 5 && rowok) {
                        const int colk = wc * 32 + fq * 8;
                        float* dst;
                        if (row < 16384) dst = out + (bj == 0 ? off_kp : off_vp) + ((size_t)layer * 16384 + row) * 128 + colk;
                        else dst = out + (bj == 0 ? off_ks : off_vs) + ((size_t)layer * 128 + (row - 16384)) * 128 + colk;
                        *(f32x4*)dst = v0; *(f32x4*)(dst + 4) = v1;
                    }
                    if (pn == 8 && bj == 0 && rowok) {
                        if (wc < 2) {
                            const int colk = wc * 32 + fq * 8;
                            float* dst;
                            if (row < 16384) dst = out + off_kip + ((size_t)layer * 16384 + row) * 64 + colk;
                            else dst = out + off_kis + ((size_t)layer * 128 + (row - 16384)) * 64 + colk;
                            *(f32x4*)dst = v0; *(f32x4*)(dst + 4) = v1;
                        } else if (wc == 2 && fq == 0) {
                            const float sc = 0.35355339059327373f;
                            *(f32x4*)(WI + (size_t)row * 8) = v0 * sc; *(f32x4*)(WI + (size_t)row * 8 + 4) = v1 * sc;
                        }
                    }
                }
            }
    }
};
struct EpiResF32 {
    static constexpr bool PERM = false, AFTER_DRAIN = false;
    const float* X; float* Y; float alpha;
    __device__ __forceinline__ void operator()(const f32x4 (&acc)[2][2][4][2], const Unit& u, int wr, int wc, int fr, int fq) const {
        const int col0 = u.pn * BM + wc * 32 + 4 * fq;
#pragma unroll
        for (int ai = 0; ai < 2; ++ai)
#pragma unroll
            for (int m = 0; m < 4; ++m) {
                const size_t off = (size_t)(u.pm * BM + ai * HALF + wr * 64 + m * 16 + fr) * 1024 + col0;
#pragma unroll
                for (int bj = 0; bj < 2; ++bj)
#pragma unroll
                    for (int n = 0; n < 2; ++n) {
                        const f32x4 xv = *(const f32x4*)(X + off + bj * HALF + n * 16);
                        *(f32x4*)(Y + off + bj * HALF + n * 16) = xv * alpha + acc[ai][bj][m][n];
                    }
            }
    }
};
struct EpiPlainBf16 {
    static constexpr bool PERM = true, AFTER_DRAIN = false;
    bf16_t* O; int ldc;
    __device__ __forceinline__ void operator()(const f32x4 (&acc)[2][2][4][2], const Unit& u, int wr, int wc, int fr, int fq) const {
        const int col0 = u.pn * BM + wc * 32 + 8 * fq;
#pragma unroll
        for (int ai = 0; ai < 2; ++ai)
#pragma unroll
            for (int m = 0; m < 4; ++m) {
                bf16_t* rowp = O + (size_t)(u.pm * BM + ai * HALF + wr * 64 + m * 16 + fr) * ldc + col0;
#pragma unroll
                for (int bj = 0; bj < 2; ++bj) {
                    const f32x4 v0 = acc[ai][bj][m][0], v1 = acc[ai][bj][m][1];
                    u32x4 w; w.x = cvt_pk_bf16(v0[0], v0[1]); w.y = cvt_pk_bf16(v0[2], v0[3]); w.z = cvt_pk_bf16(v1[0], v1[1]); w.w = cvt_pk_bf16(v1[2], v1[3]);
                    *(u32x4*)(rowp + bj * HALF) = w;
                }
            }
    }
};
template <class Epi, class Sched, bool ALIGN_EPI = false, bool SP2 = false>
__device__ __forceinline__ void gemm_phase(PG8_LAS unsigned char* lds, const Gemm g, const Sched& S, const Epi& E) {
    int tid_ = threadIdx.x; asm volatile("" : "+v"(tid_));
    const int tid = tid_, wid = __builtin_amdgcn_readfirstlane(tid >> 6), lane = tid & 63, wr = wid >> 2, wc = wid & 3, fr = lane & 15, fq = lane >> 4;
    const int K = g.K, nt = K / BK;
    unsigned voffA[2], voffB[2];
#pragma unroll
    for (int i = 0; i < 2; ++i) { int R, C; stage_rc(tid * 16 + i * 8192, R, C); const int Rb = Epi::PERM ? ((R & ~31) + perm32(R & 31)) : R;
        voffA[i] = (unsigned)(R * K + C) * 2u; voffB[i] = (unsigned)(Rb * K + C) * 2u; }
    const size_t kstep = (size_t)(BK * 2);
    const size_t hstep = (size_t)HALF * K * 2;
    const size_t tstep = 2 * hstep;
    const unsigned ldsw = (unsigned)wid * 1024u;
    const int aoff = lds_byte(wr * 64 + fr, fq * 8), boff = lds_byte(wc * 32 + fr, fq * 8);
#define PG8_SA(b, h) (((b) * 2 + (h)) * HTB)
#define PG8_SB(b, h) ((4 + (b) * 2 + (h)) * HTB)
#define PG8_STAGE(bufoff, gbase, voff) do { _Pragma("unroll") for (int _i = 0; _i < 2; ++_i) \
        __builtin_amdgcn_global_load_lds((const unsigned*)((const char*)(gbase) + (voff)[_i]), (PG8_LAS unsigned*)(lds + (bufoff) + ldsw + _i * 8192), 16, 0, 0); } while (0)
#define PG8_LDA(dst, b, h) do { _Pragma("unroll") for (int m = 0; m < 4; ++m) _Pragma("unroll") for (int k = 0; k < 2; ++k) dst[m][k] = *(const PG8_LAS bf16x8*)(lds + PG8_SA(b, h) + aoff + m * 2048 + k * 1024); } while (0)
#define PG8_LDB(dst, b, h) do { _Pragma("unroll") for (int n = 0; n < 2; ++n) _Pragma("unroll") for (int k = 0; k < 2; ++k) dst[n][k] = *(const PG8_LAS bf16x8*)(lds + PG8_SB(b, h) + boff + n * 2048 + k * 1024); } while (0)
#define PG8_MMA(ai, bj, At, Bt) do { __builtin_amdgcn_s_setprio(1); _Pragma("unroll") for (int m = 0; m < 4; ++m) _Pragma("unroll") for (int n = 0; n < 2; ++n) _Pragma("unroll") for (int k = 0; k < 2; ++k) \
        acc[ai][bj][m][n] = __builtin_amdgcn_mfma_f32_16x16x32_bf16(Bt[n][k], At[m][k], acc[ai][bj][m][n], 0, 0, 0); __builtin_amdgcn_s_setprio(0); } while (0)
#define PG8_WAIT_V(n) asm volatile("s_waitcnt vmcnt(" #n ")" ::: "memory")
#define PG8_WAIT_L(n) asm volatile("s_waitcnt lgkmcnt(" #n ")" ::: "memory")
#define PG8_BAR __builtin_amdgcn_s_barrier()
#define PG8_SCHED __builtin_amdgcn_sched_barrier(0)
    Unit cur, nxt; int ui = 0;
    if (!S.next(0, cur)) return;
    f32x4 acc[2][2][4][2];
#pragma unroll
    for (int a = 0; a < 2; ++a)
#pragma unroll
        for (int b = 0; b < 2; ++b)
#pragma unroll
            for (int m = 0; m < 4; ++m)
#pragma unroll
                for (int n = 0; n < 2; ++n) acc[a][b][m][n] = (f32x4){0.f, 0.f, 0.f, 0.f};
    bf16x8 At[4][2], B0[2][2], B1[2][2];
    const char* cA = (const char*)g.A + (size_t)cur.pm * tstep; const char* cB = (const char*)g.Bt + (size_t)cur.pn * tstep;
    S.a_ready(cur);
    if constexpr (SP2) {
        PG8_STAGE(PG8_SB(0, 0), cB, voffB); PG8_STAGE(PG8_SB(0, 1), cB + hstep, voffB); PG8_STAGE(PG8_SA(0, 0), cA, voffA); PG8_STAGE(PG8_SA(0, 1), cA + hstep, voffA);
        if (wr == 1) PG8_BAR;
        PG8_WAIT_V(2); PG8_BAR;
        PG8_STAGE(PG8_SB(1, 0), cB + kstep, voffB); PG8_STAGE(PG8_SA(1, 0), cA + kstep, voffA); PG8_STAGE(PG8_SB(1, 1), cB + hstep + kstep, voffB);
        PG8_WAIT_V(6); PG8_BAR;
    } else {
        PG8_STAGE(PG8_SB(0, 0), cB, voffB); PG8_STAGE(PG8_SA(0, 0), cA, voffA); PG8_STAGE(PG8_SB(0, 1), cB + hstep, voffB); PG8_STAGE(PG8_SA(0, 1), cA + hstep, voffA);
        if (wr == 1) PG8_BAR;
        PG8_WAIT_V(4); PG8_BAR;
        PG8_STAGE(PG8_SB(1, 0), cB + kstep, voffB); PG8_STAGE(PG8_SA(1, 0), cA + kstep, voffA); PG8_STAGE(PG8_SB(1, 1), cB + hstep + kstep, voffB);
        PG8_WAIT_V(6); PG8_BAR;
    }
    for (;;) {
        const bool has_next = S.next(ui + 1, nxt);
        const char* nA = has_next ? (const char*)g.A + (size_t)nxt.pm * tstep : cA; const char* nB = has_next ? (const char*)g.Bt + (size_t)nxt.pn * tstep : cB;
        for (int t = 0; t < nt; t += 2) {
            const bool last = (t == nt - 2);
            const char* a1 = cA + (size_t)(t + 1) * kstep;
            const char* a2 = last ? nA : cA + (size_t)(t + 2) * kstep; const char* b2 = last ? nB : cB + (size_t)(t + 2) * kstep;
            const char* a3 = a2 + kstep; const char* b3 = b2 + kstep;
            if (last && has_next) S.a_ready(nxt);
            if constexpr (SP2) {
            PG8_LDB(B0, 0, 0); PG8_LDB(B1, 0, 1); PG8_SCHED; PG8_LDA(At, 0, 0); PG8_STAGE(PG8_SA(1, 1), a1 + hstep, voffA);
            PG8_WAIT_V(8); PG8_WAIT_L(0); PG8_BAR; PG8_MMA(0, 0, At, B0); PG8_MMA(0, 1, At, B1); PG8_BAR; PG8_SCHED;
            PG8_LDA(At, 0, 1); PG8_STAGE(PG8_SB(0, 0), b2, voffB); PG8_STAGE(PG8_SB(0, 1), b2 + hstep, voffB); PG8_STAGE(PG8_SA(0, 0), a2, voffA);
            PG8_WAIT_V(8); PG8_WAIT_L(0); PG8_BAR; PG8_MMA(1, 0, At, B0); PG8_MMA(1, 1, At, B1); PG8_BAR; PG8_SCHED;
            PG8_LDB(B0, 1, 0); PG8_LDB(B1, 1, 1); PG8_SCHED; PG8_LDA(At, 1, 0); PG8_STAGE(PG8_SA(0, 1), a2 + hstep, voffA);
            PG8_WAIT_V(8); PG8_WAIT_L(0); PG8_BAR; PG8_MMA(0, 0, At, B0); PG8_MMA(0, 1, At, B1); PG8_BAR; PG8_SCHED;
            PG8_LDA(At, 1, 1); PG8_STAGE(PG8_SB(1, 0), b3, voffB); PG8_STAGE(PG8_SB(1, 1), b3 + hstep, voffB); PG8_STAGE(PG8_SA(1, 0), a3, voffA);
            PG8_WAIT_V(8); PG8_WAIT_L(0); PG8_BAR; PG8_MMA(1, 0, At, B0); PG8_MMA(1, 1, At, B1); PG8_BAR; PG8_SCHED;
            } else {
            PG8_LDB(B0, 0, 0); PG8_SCHED; PG8_LDA(At, 0, 0); PG8_STAGE(PG8_SA(1, 1), a1 + hstep, voffA);
            PG8_WAIT_L(8); PG8_BAR; PG8_WAIT_L(0); PG8_MMA(0, 0, At, B0); PG8_BAR; PG8_SCHED;
            PG8_LDB(B1, 0, 1); PG8_STAGE(PG8_SB(0, 0), b2, voffB);
            PG8_BAR; PG8_WAIT_L(0); PG8_MMA(0, 1, At, B1); PG8_BAR;
            PG8_LDA(At, 0, 1); PG8_STAGE(PG8_SA(0, 0), a2, voffA);
            PG8_BAR; PG8_WAIT_L(0); PG8_MMA(1, 0, At, B0); PG8_BAR; PG8_SCHED;
            PG8_STAGE(PG8_SB(0, 1), b2 + hstep, voffB);
            PG8_WAIT_V(6); PG8_BAR; PG8_MMA(1, 1, At, B1); PG8_BAR;
            PG8_LDB(B0, 1, 0); PG8_SCHED; PG8_LDA(At, 1, 0); PG8_STAGE(PG8_SA(0, 1), a2 + hstep, voffA);
            PG8_WAIT_L(8); PG8_BAR; PG8_WAIT_L(0); PG8_MMA(0, 0, At, B0); PG8_BAR; PG8_SCHED;
            PG8_LDB(B1, 1, 1); PG8_STAGE(PG8_SB(1, 0), b3, voffB);
            PG8_BAR; PG8_WAIT_L(0); PG8_MMA(0, 1, At, B1); PG8_BAR;
            PG8_LDA(At, 1, 1); PG8_STAGE(PG8_SA(1, 0), a3, voffA);
            PG8_BAR; PG8_WAIT_L(0); PG8_MMA(1, 0, At, B0); PG8_BAR; PG8_SCHED;
            PG8_STAGE(PG8_SB(1, 1), b3 + hstep, voffB);
            PG8_WAIT_V(6); PG8_BAR; PG8_MMA(1, 1, At, B1); PG8_BAR;
            }
        }
        if constexpr (ALIGN_EPI) { if (wr == 0) PG8_BAR; }
        if constexpr (!Epi::AFTER_DRAIN) { E(acc, cur, wr, wc, fr, fq); S.done(cur); }
        if (!has_next) break;
#pragma unroll
        for (int a = 0; a < 2; ++a)
#pragma unroll
            for (int b = 0; b < 2; ++b)
#pragma unroll
                for (int m = 0; m < 4; ++m)
#pragma unroll
                    for (int n = 0; n < 2; ++n) acc[a][b][m][n] = (f32x4){0.f, 0.f, 0.f, 0.f};
        cur = nxt; cA = nA; cB = nB; ++ui;
        if constexpr (ALIGN_EPI) { if (wr == 1) PG8_BAR; }
    }
    PG8_WAIT_V(0);
    if constexpr (!ALIGN_EPI) { if (wr == 0) PG8_BAR; }
    PG8_BAR;
    if constexpr (Epi::AFTER_DRAIN) { E.fused(acc, cur, wr, wc, fr, fq, lds, wid, lane); S.done(cur); }
#undef PG8_SA
#undef PG8_SB
#undef PG8_STAGE
#undef PG8_LDA
#undef PG8_LDB
#undef PG8_MMA
#undef PG8_WAIT_V
#undef PG8_WAIT_L
#undef PG8_BAR
#undef PG8_SCHED
}
}
#define GAS __attribute__((address_space(1)))
#define LAS __attribute__((address_space(3)))
typedef unsigned short bf16;
typedef unsigned v4u __attribute__((ext_vector_type(4)));
typedef float f32x4 __attribute__((ext_vector_type(4)));
typedef short bf16x8 __attribute__((ext_vector_type(8)));
typedef GAS unsigned gu32;
typedef GAS unsigned long long gu64;
#define RLX_AGENT __ATOMIC_RELAXED, __HIP_MEMORY_SCOPE_AGENT
#define LDS_WAIT() asm volatile("s_waitcnt lgkmcnt(0)" ::: "memory")
#define VM_WAIT() asm volatile("s_waitcnt vmcnt(0)" ::: "memory")
__device__ __forceinline__ unsigned long long rt() { return __builtin_amdgcn_s_memrealtime(); }
__device__ __forceinline__ unsigned f2bf(float f) { unsigned u = __builtin_bit_cast(unsigned, f); return (u + 0x7fffu + ((u >> 16) & 1u)) >> 16; }
__device__ __forceinline__ unsigned pk2(float lo, float hi) { return f2bf(lo) | (f2bf(hi) << 16); }

#define XB_TMO      128
#define XB_XCNT(j)  (256  + 64 * (j))
#define XB_XSUB(j)  (1280 + 64 * (j))
#define XB_XGEN(j)  (2304 + 64 * (j))
#define XB_TOP      3328
#define XB_TOPGEN   3392
#define XCD_BAR_WORDS 3456
#define XB_SPIN_CAP (1u << 18)

__device__ __forceinline__ unsigned xb_ld(unsigned* p)              { return __hip_atomic_load(p, __ATOMIC_RELAXED, __HIP_MEMORY_SCOPE_AGENT); }
__device__ __forceinline__ unsigned xb_add(unsigned* p, unsigned v) { return __hip_atomic_fetch_add(p, v, __ATOMIC_RELAXED, __HIP_MEMORY_SCOPE_AGENT); }
__device__ __forceinline__ unsigned xb_xcc_id() { return (unsigned)__builtin_amdgcn_s_getreg((3 << 11) | 20) & 0xFu; }
#define XB_SPIN(cond, bar) do { unsigned _sp = 0; while (cond) { __builtin_amdgcn_s_sleep(1); \
    if ((++_sp & 255u) == 0u) { if (xb_ld(&(bar)[XB_TMO])) break; if (_sp > XB_SPIN_CAP) { atomicAdd(&(bar)[XB_TMO], 1u); break; } } } } while (0)

struct XcdBarrier {
    unsigned* bar; unsigned x;
    volatile LAS unsigned* st;
};

__device__ __forceinline__ XcdBarrier xcd_barrier_post(unsigned* bar, volatile LAS unsigned* st) {
    XcdBarrier b; b.bar = bar; b.x = xb_xcc_id(); b.st = st;
    if (threadIdx.x == 0) (void)xb_add(&bar[XB_XCNT(b.x)], 1u);
    return b;
}
__device__ __forceinline__ void xcd_barrier_complete(unsigned* bar, unsigned x, unsigned& nloc, unsigned& nx) {
    const unsigned G = gridDim.x * gridDim.y * gridDim.z;
    unsigned sum, cnt, mine, sp = 0u;
    for (;;) {
        sum = 0u; cnt = 0u; mine = 0u;
#pragma unroll
        for (unsigned j = 0; j < 16; ++j) { const unsigned c = xb_ld(&bar[XB_XCNT(j)]); sum += c; cnt += (c > 0u) ? 1u : 0u; mine = (j == x) ? c : mine; }
        if (sum == G) break;
        __builtin_amdgcn_s_sleep(1);
        if ((++sp & 255u) == 0u) { if (xb_ld(&bar[XB_TMO])) break; if (sp > XB_SPIN_CAP) { atomicAdd(&bar[XB_TMO], 1u); break; } }
    }
    nloc = mine > 0u ? mine : 1u; nx = cnt > 0u ? cnt : 1u;
}

__device__ __forceinline__ void xcd_barrier(const XcdBarrier& b) {
    asm volatile("s_waitcnt vmcnt(0)" ::: "memory");
    __syncthreads();
    if (threadIdx.x == 0) {
        unsigned* bar = b.bar;
        __builtin_amdgcn_s_waitcnt(0);
        unsigned nloc = b.st[0], nx = b.st[1];
        if (nloc == 0u) { xcd_barrier_complete(bar, b.x, nloc, nx); b.st[0] = nloc; b.st[1] = nx; }
        const unsigned old = xb_add(&bar[XB_XSUB(b.x)], 1u);
        const unsigned gen = old / nloc;
        if (old + 1u == (gen + 1u) * nloc) {
            __builtin_amdgcn_fence(__ATOMIC_RELEASE, "agent");
            asm volatile("s_waitcnt vmcnt(0)" ::: "memory");
            const unsigned og = xb_add(&bar[XB_TOP], 1u);
            const unsigned tg = og / nx;
            if (og + 1u == (tg + 1u) * nx) xb_add(&bar[XB_TOPGEN], 1u);
            else XB_SPIN(xb_ld(&bar[XB_TOPGEN]) == tg, bar);
            __builtin_amdgcn_fence(__ATOMIC_ACQUIRE, "agent");
            xb_add(&bar[XB_XGEN(b.x)], 1u);
            asm volatile("s_waitcnt vmcnt(0)" ::: "memory");
        } else {
            XB_SPIN(xb_ld(&bar[XB_XGEN(b.x)]) == gen, bar);
            __builtin_amdgcn_fence(__ATOMIC_ACQUIRE, "agent");
            asm volatile("s_waitcnt vmcnt(0)" ::: "memory");
        }
    }
    __syncthreads();
}

typedef float f32x16 __attribute__((ext_vector_type(16)));
typedef unsigned u32x2 __attribute__((ext_vector_type(2)));
typedef unsigned u32x4 __attribute__((ext_vector_type(4)));
typedef __bf16 bf16x2_t __attribute__((ext_vector_type(2)));
constexpr int NWAVES = 8;
constexpr int DM = 1024, NB = 2, SEQ = 8192, DEPTH = 4, DB = 32, DT = 4, NPAGES = 64, NPOOL = 2560;
constexpr int MP = NB * SEQ, MS = DB * DT, MR = MP + MS, MPAD = 16640;
constexpr int NIN = 2632, NINP = 2816, DFF = 2816, NUP = 5632;
constexpr int HC_GB = 0, HC_GC = 256, HC_HA = 512, HC_Q = 768, HC_K = 1280, HC_V = 1408, HC_QI = 1536, HC_KI = 2048, HC_U = 2304, HC_VC = 2560;
constexpr float LN_EPS = 1e-5f;
constexpr float ALPHA = 1.681792830507429f;
constexpr size_t OFF_YP = 0, OFF_YS = OFF_YP + (size_t)MP * DM, OFF_KP = OFF_YS + (size_t)MS * DM, OFF_KS = OFF_KP + (size_t)DEPTH * MP * 128,
    OFF_VP = OFF_KS + (size_t)DEPTH * MS * 128, OFF_VS = OFF_VP + (size_t)DEPTH * MP * 128, OFF_KIP = OFF_VS + (size_t)DEPTH * MS * 128,
    OFF_KIS = OFF_KIP + (size_t)DEPTH * MP * 64, OFF_CP = OFF_KIS + (size_t)DEPTH * MS * 64, OFF_CS = OFF_CP + (size_t)DEPTH * NB * 2 * 256,
    OFF_FP = OFF_CS + (size_t)DEPTH * DB * 2 * 256, OFF_FS = OFF_FP + (size_t)DEPTH * NB * 2 * NUP, OFF_CH = OFF_FS + (size_t)DEPTH * DB * 2 * NUP,
    OUT_TOTAL = OFF_CH + (size_t)DEPTH * MS * 256;
static_assert(OUT_TOTAL == 39776256, "output size");
constexpr size_t MiB = 1u << 20;
constexpr size_t WS_CTL = 0, CTL_ZERO_BYTES = 1 * MiB;
constexpr size_t WS_ROPE = 1 * MiB, WS_WTRIL = 2 * MiB, WS_WIN = 4 * MiB, WS_WO = 26 * MiB, WS_WUP = 34 * MiB, WS_WDN = 78 * MiB;
constexpr size_t WS_X = 100 * MiB, WS_XB = 165 * MiB, WS_H = 198 * MiB, WS_WI = 288 * MiB, WS_CAT = 289 * MiB, WS_Y = 322 * MiB;
constexpr size_t WS_Z = 387 * MiB, WS_A2 = 566 * MiB, WS_PB = 656 * MiB, WS_PC = 752 * MiB, WS_SS = 753 * MiB, WS_END = 758 * MiB;
constexpr int SS_PITCH = 8256;
constexpr int CW_TMO = 0, CW_BAR = 4096;
constexpr int LDS_BYTES = 163840;
constexpr int MISC_OFF = 163840 - 256;
constexpr int L_HIST = 131072, L_KT = 133120, KT_PITCH = 144, KT_BYTES = 64 * KT_PITCH;
static_assert(L_KT + 2 * KT_BYTES <= MISC_OFF, "LDS map");
constexpr int W_UNI = 0, W_S = 6144, W_SEL = 14336, W_HIST = 15360, W_INV = 15616;

__device__ __forceinline__ float wave_sum_f(float v) {
#pragma unroll
    for (int o = 1; o < 64; o <<= 1) v += __shfl_xor(v, o);
    return v;
}
__device__ __forceinline__ float wave_max_f(float v) {
#pragma unroll
    for (int o = 1; o < 64; o <<= 1) v = fmaxf(v, __shfl_xor(v, o));
    return v;
}
__device__ __forceinline__ unsigned wave_min_u(unsigned v) {
#pragma unroll
    for (int o = 1; o < 64; o <<= 1) { const unsigned t = (unsigned)__shfl_xor((int)v, o); v = t < v ? t : v; }
    return v;
}
__device__ __forceinline__ unsigned wave_max_u(unsigned v) {
#pragma unroll
    for (int o = 1; o < 64; o <<= 1) { const unsigned t = (unsigned)__shfl_xor((int)v, o); v = t > v ? t : v; }
    return v;
}
#define WAVE_SYNC() do { asm volatile("s_waitcnt lgkmcnt(0)" ::: "memory"); __builtin_amdgcn_wave_barrier(); asm volatile("" ::: "memory"); } while (0)
__device__ __forceinline__ float bf_lo(unsigned u) { return __uint_as_float(u << 16); }
__device__ __forceinline__ float bf_hi(unsigned u) { return __uint_as_float(u & 0xffff0000u); }
__device__ __forceinline__ unsigned ord_u(float f) { const unsigned u = __float_as_uint(f); return (u & 0x80000000u) ? ~u : (u | 0x80000000u); }

template <int NPL>
__device__ __forceinline__ unsigned wave_select(const LAS unsigned* buf, int n, int K, int LIMIT, LAS unsigned* hist, int lane, unsigned (&e)[NPL]) {
    unsigned mn = 0xffffffffu, mx = 0u;
#pragma unroll
    for (int i = 0; i < NPL; ++i) { const int idx = i * 64 + lane; const bool v = idx < n; e[i] = v ? buf[idx] : 0u; if (v) { mn = e[i] < mn ? e[i] : mn; mx = e[i] > mx ? e[i] : mx; } }
    unsigned lo = wave_min_u(mn), hi = wave_max_u(mx); int above = 0;
    for (int iter = 0; iter < 8; ++iter) {
        const unsigned range = hi - lo;
        int s = 26 - (int)__builtin_clz(range | 1u); s = s < 0 ? 0 : s;
        WAVE_SYNC();
        hist[lane] = 0u;
        WAVE_SYNC();
#pragma unroll
        for (int i = 0; i < NPL; ++i) { const int idx = i * 64 + lane; if (idx < n && e[i] >= lo && e[i] <= hi) __hip_atomic_fetch_add(&hist[(e[i] - lo) >> s], 1u, __ATOMIC_RELAXED, __HIP_MEMORY_SCOPE_WORKGROUP); }
        WAVE_SYNC();
        unsigned S = hist[lane];
#pragma unroll
        for (int d = 1; d < 64; d <<= 1) { const unsigned y = (unsigned)__shfl_down((int)S, d); if (lane + d < 64) S += y; }
        const int Kc = K - above;
        const unsigned long long m = __ballot((int)S >= Kc);
        const int bs = m ? 63 - (int)__builtin_clzll(m) : 0;
        const unsigned Sb = (unsigned)__shfl((int)S, bs), Sb1 = bs < 63 ? (unsigned)__shfl((int)S, bs + 1) : 0u;
        const unsigned edge = lo + ((unsigned)bs << s);
        if (above + (int)Sb <= LIMIT || s == 0) return edge;
        above += (int)Sb1; lo = edge;
        const unsigned w1 = (1u << s) - 1u; const unsigned nh = (edge > 0xffffffffu - w1) ? 0xffffffffu : edge + w1; hi = nh < hi ? nh : hi;
    }
    return lo;
}
template <int NPL>
__device__ __forceinline__ int wave_compact(LAS unsigned* buf, int n, unsigned tau, int lane, const unsigned (&e)[NPL]) {
    int base = 0;
    WAVE_SYNC();
#pragma unroll
    for (int i = 0; i < NPL; ++i) { const int idx = i * 64 + lane; const bool keep = idx < n && e[i] >= tau; const unsigned long long m = __ballot(keep);
        const int pos = base + (int)__builtin_amdgcn_mbcnt_hi((unsigned)(m >> 32), __builtin_amdgcn_mbcnt_lo((unsigned)m, 0u)); if (keep) buf[pos] = e[i]; base += (int)__builtin_popcountll(m); }
    WAVE_SYNC();
    return base;
}
__device__ __forceinline__ f32x4 ld4bf(const bf16* p) { const u32x2 v = *(const u32x2*)p; return (f32x4){bf_lo(v.x), bf_hi(v.x), bf_lo(v.y), bf_hi(v.y)}; }

constexpr int ITEMS_PER_BATCH = 128 * 129 / 2, ITEMS = 2 * ITEMS_PER_BATCH;
__device__ __forceinline__ int cu_of_item(int L, int G) { return (int)((((long)L + 1) * G - 1) / ITEMS); }
__device__ __forceinline__ unsigned pack13(float sc, int idx) { return (ord_u(sc) & 0xffffe000u) | (unsigned)(8191 - idx); }
__device__ __forceinline__ unsigned pack14(float sc, int idx) { return (ord_u(sc) & 0xffffc000u) | (unsigned)(16383 - idx); }
__device__ __forceinline__ void rho_map(int rho, int& q4, int& h) { const int a = rho >> 3, hr = (rho >> 2) & 1, i = rho & 3; q4 = 2 * hr + (a >> 1); h = 4 * (a & 1) + i; }

__device__ __forceinline__ void p2a_segment(LAS unsigned char* lds, const bf16* H, const float* WI, unsigned* PB, int* PC,
                                            int b, int j, int it_lo, int it_hi, int part, int tid, int wid, int lane) {
    const int c = lane & 31, hi = lane >> 5;
    const int rowq0 = b * SEQ + 64 * j;
    LAS unsigned* cand = (LAS unsigned*)(lds + wid * 16384);
    LAS unsigned* hist = (LAS unsigned*)(lds + L_HIST + wid * 256);
    bf16x8 A[2][4];
    { int q4, h; rho_map(c, q4, h);
#pragma unroll
      for (int T = 0; T < 2; ++T) { const bf16* src = H + (size_t)(rowq0 + 8 * wid + 4 * T + q4) * NINP + HC_QI + h * 64 + hi * 8;
#pragma unroll
          for (int ks = 0; ks < 4; ++ks) A[T][ks] = *(const bf16x8*)(src + ks * 16); } }
    float wq[2][2][8]; int tq[2][2];
#pragma unroll
    for (int T = 0; T < 2; ++T)
#pragma unroll
        for (int x = 0; x < 2; ++x) { const int ql = 8 * wid + 4 * T + 2 * hi + x; const float* wp = WI + (size_t)(rowq0 + ql) * 8;
            const f32x4 w0 = *(const f32x4*)wp, w1 = *(const f32x4*)(wp + 4);
            wq[T][x][0] = w0[0]; wq[T][x][1] = w0[1]; wq[T][x][2] = w0[2]; wq[T][x][3] = w0[3]; wq[T][x][4] = w1[0]; wq[T][x][5] = w1[1]; wq[T][x][6] = w1[2]; wq[T][x][7] = w1[3];
            tq[T][x] = 64 * j + ql; }
    int cnt[8]; unsigned tau[8];
#pragma unroll
    for (int q = 0; q < 8; ++q) { cnt[q] = 0; tau[q] = 0u; }
    const int krow = tid >> 3, kch = tid & 7;
    const bf16* ksrc = H + (size_t)(b * SEQ + krow) * NINP + HC_KI + kch * 8;
    LAS unsigned char* kt = lds + L_KT;
    const int kdst = krow * KT_PITCH + kch * 16;
    __syncthreads();
    { const u32x4 v = *(const u32x4*)(ksrc + (size_t)(64 * it_lo) * NINP); *(LAS u32x4*)(kt + kdst) = v; }
    __syncthreads();
    int cur = 0;
    for (int it = it_lo; it < it_hi; ++it) {
        u32x4 nxt = (u32x4){0u, 0u, 0u, 0u};
        const bool more = (it + 1 < it_hi);
        if (more) nxt = *(const u32x4*)(ksrc + (size_t)(64 * (it + 1)) * NINP);
        const LAS unsigned char* ktb = kt + cur * KT_BYTES;
#pragma unroll
        for (int st = 0; st < 2; ++st) {
            int mxc = cnt[0];
#pragma unroll
            for (int q = 1; q < 8; ++q) mxc = cnt[q] > mxc ? cnt[q] : mxc;
            if (mxc > 480) {
#pragma unroll
                for (int q = 0; q < 8; ++q) if (cnt[q] > 400) { unsigned e[8]; const unsigned t = wave_select<8>(cand + q * 512, cnt[q], 256, 384, hist, lane, e); cnt[q] = wave_compact<8>(cand + q * 512, cnt[q], t, lane, e); tau[q] = t; }
            }
            bf16x8 bfr[4];
#pragma unroll
            for (int ks = 0; ks < 4; ++ks) bfr[ks] = *(const LAS bf16x8*)(ktb + (32 * st + c) * KT_PITCH + ks * 32 + hi * 16);
            f32x16 acc[2];
#pragma unroll
            for (int r = 0; r < 16; ++r) { acc[0][r] = 0.f; acc[1][r] = 0.f; }
#pragma unroll
            for (int ks = 0; ks < 4; ++ks) { acc[0] = __builtin_amdgcn_mfma_f32_32x32x16_bf16(A[0][ks], bfr[ks], acc[0], 0, 0, 0); acc[1] = __builtin_amdgcn_mfma_f32_32x32x16_bf16(A[1][ks], bfr[ks], acc[1], 0, 0, 0); }
            const int s = 64 * it + 32 * st + c;
#pragma unroll
            for (int T = 0; T < 2; ++T)
#pragma unroll
                for (int x = 0; x < 2; ++x) {
                    float sc = 0.f;
#pragma unroll
                    for (int k = 0; k < 8; ++k) sc = fmaf(wq[T][x][k], fmaxf(acc[T][8 * x + k], 0.f), sc);
                    const unsigned key = pack13(sc, s);
                    const int qA = 4 * T + x, qB = 4 * T + 2 + x;
                    const unsigned tl = hi ? tau[qB] : tau[qA];
                    const bool pass = (s <= tq[T][x]) && key >= tl;
                    const unsigned long long m = __ballot(pass);
                    if (m) {
                        const unsigned mlo = (unsigned)m, mhi = (unsigned)(m >> 32);
                        const int pos = hi ? cnt[qB] + (int)__builtin_amdgcn_mbcnt_hi(mhi, 0u) : cnt[qA] + (int)__builtin_amdgcn_mbcnt_lo(mlo, 0u);
                        if (pass) cand[(hi ? qB : qA) * 512 + pos] = key;
                        cnt[qA] += (int)__builtin_popcount(mlo); cnt[qB] += (int)__builtin_popcount(mhi);
                    }
                }
        }
        if (more) *(LAS u32x4*)(kt + (cur ^ 1) * KT_BYTES + kdst) = nxt;
        __syncthreads();
        cur ^= 1;
    }
#pragma unroll
    for (int q = 0; q < 8; ++q) {
        if (cnt[q] > 320) { unsigned e[8]; const unsigned t = wave_select<8>(cand + q * 512, cnt[q], 256, 320, hist, lane, e); cnt[q] = wave_compact<8>(cand + q * 512, cnt[q], t, lane, e); }
        const size_t slot = (size_t)((b * 128 + j) * 3 + part) * 64 + 8 * wid + q;
        unsigned* dst = PB + slot * 512;
        WAVE_SYNC();
        for (int k = lane; k < cnt[q]; k += 64) dst[k] = cand[q * 512 + k];
        if (lane == 0) PC[slot] = cnt[q];
    }
}

__device__ __forceinline__ void p2a_prompt(LAS unsigned char* lds, const bf16* H, const float* WI, unsigned* PB, int* PC, int vcu, int G, int tid, int wid, int lane) {
    const int Llo = (int)((long)vcu * ITEMS / G), Lhi = (int)((long)(vcu + 1) * ITEMS / G);
    int L = Llo;
    while (L < Lhi) {
        const int b = L >= ITEMS_PER_BATCH ? 1 : 0; const int r = L - b * ITEMS_PER_BATCH;
        int j = (int)((sqrtf(8.f * (float)r + 1.f) - 1.f) * 0.5f);
        while ((j + 1) * (j + 2) / 2 <= r) ++j;
        while (j * (j + 1) / 2 > r) --j;
        const int it0 = r - j * (j + 1) / 2;
        int nit = j + 1 - it0; if (nit > Lhi - L) nit = Lhi - L;
        const int part = vcu - cu_of_item(b * ITEMS_PER_BATCH + j * (j + 1) / 2, G);
        p2a_segment(lds, H, WI, PB, PC, b, j, it0, it0 + nit, part, tid, wid, lane);
        L += nit;
    }
}

__device__ __forceinline__ void p2a_sample_unit(const bf16* H, const float* WI, const float* ckidx_l, const int* page_table, unsigned* SS, int bd, int pg, int lane) {
    const int c = lane & 31, hi = lane >> 5;
    bf16x8 A[4];
    { int q4, h; rho_map(c, q4, h); const bf16* src = H + (size_t)(MP + 4 * bd + q4) * NINP + HC_QI + h * 64 + hi * 8;
#pragma unroll
      for (int ks = 0; ks < 4; ++ks) A[ks] = *(const bf16x8*)(src + ks * 16); }
    float wq[2][8];
#pragma unroll
    for (int x = 0; x < 2; ++x) { const float* wp = WI + (size_t)(MP + 4 * bd + 2 * hi + x) * 8; const f32x4 w0 = *(const f32x4*)wp, w1 = *(const f32x4*)(wp + 4);
        wq[x][0] = w0[0]; wq[x][1] = w0[1]; wq[x][2] = w0[2]; wq[x][3] = w0[3]; wq[x][4] = w1[0]; wq[x][5] = w1[1]; wq[x][6] = w1[2]; wq[x][7] = w1[3]; }
    const int phys = page_table[bd * NPAGES + pg];
    const float* kp = ckidx_l + ((size_t)phys * 128) * 64;
    const int nst = (pg == NPAGES - 1) ? 5 : 4;
    for (int st = 0; st < nst; ++st) {
        bf16x8 bfr[4];
        if (st < 4) {
            const float* rp = kp + (size_t)(32 * st + c) * 64 + hi * 8;
#pragma unroll
            for (int ks = 0; ks < 4; ++ks) { const f32x4 a = *(const f32x4*)(rp + ks * 16), bq = *(const f32x4*)(rp + ks * 16 + 4);
                u32x4 w; w.x = pg8::cvt_pk_bf16(a[0], a[1]); w.y = pg8::cvt_pk_bf16(a[2], a[3]); w.z = pg8::cvt_pk_bf16(bq[0], bq[1]); w.w = pg8::cvt_pk_bf16(bq[2], bq[3]);
                bfr[ks] = __builtin_bit_cast(bf16x8, w); }
        } else {
            const bf16* rp = H + (size_t)(MP + 4 * bd + (c & 3)) * NINP + HC_KI + hi * 8;
#pragma unroll
            for (int ks = 0; ks < 4; ++ks) { bf16x8 v = *(const bf16x8*)(rp + ks * 16); if (c >= 4) v = (bf16x8){0, 0, 0, 0, 0, 0, 0, 0}; bfr[ks] = v; }
        }
        f32x16 acc;
#pragma unroll
        for (int r = 0; r < 16; ++r) acc[r] = 0.f;
#pragma unroll
        for (int ks = 0; ks < 4; ++ks) acc = __builtin_amdgcn_mfma_f32_32x32x16_bf16(A[ks], bfr[ks], acc, 0, 0, 0);
#pragma unroll
        for (int x = 0; x < 2; ++x) {
            float sc = 0.f;
#pragma unroll
            for (int k = 0; k < 8; ++k) sc = fmaf(wq[x][k], fmaxf(acc[8 * x + k], 0.f), sc);
            const int qq = 2 * hi + x;
            unsigned* row = SS + (size_t)(bd * 4 + qq) * SS_PITCH;
            if (st < 4) { const int s = 128 * pg + 32 * st + c; row[s] = pack14(sc, s); }
            else if (c < 4) { const int s = 8192 + c; row[s] = (c <= qq) ? pack14(sc, s) : 0u; }
        }
    }
}

template <bool SAMPLE>
__device__ __forceinline__ void attend_query(LAS unsigned char* wl, int nsel, const bf16* qrow  , const bf16* Hb  ,
                                             const float* ck_l, const float* cv_l, const int* pt  , const float* newk, const float* newv  ,
                                             bf16* orow  , int lane) {
    const int sub = lane & 15, kq = lane >> 4, g = sub >> 3, d0 = 8 * (sub & 7);
    LAS const unsigned* sel = (LAS const unsigned*)(wl + W_SEL);
    LAS float* S = (LAS float*)(wl + W_S);
    LAS float* INV = (LAS float*)(wl + W_INV);
    float qf[4][8];
    const float qs = 0.125f * 1.4426950408889634f;
#pragma unroll
    for (int hh = 0; hh < 4; ++hh) { const u32x4 v = *(const u32x4*)(qrow + HC_Q + (4 * g + hh) * 64 + d0);
        qf[hh][0] = bf_lo(v.x) * qs; qf[hh][1] = bf_hi(v.x) * qs; qf[hh][2] = bf_lo(v.y) * qs; qf[hh][3] = bf_hi(v.y) * qs;
        qf[hh][4] = bf_lo(v.z) * qs; qf[hh][5] = bf_hi(v.z) * qs; qf[hh][6] = bf_lo(v.w) * qs; qf[hh][7] = bf_hi(v.w) * qs; }
    const int niter = (nsel + 3) >> 2;
    WAVE_SYNC();
    for (int i = 0; i < niter; ++i) {
        const int ks = 4 * i + kq; const bool valid = ks < nsel; const int idx = valid ? (int)sel[ks] : 0;
        float kf[8];
        if (SAMPLE) {
            const float* rp = idx < 8192 ? ck_l + ((size_t)pt[idx >> 7] * 128 + (idx & 127)) * 128 : newk + (size_t)(idx - 8192) * 128;
            const f32x4 a = *(const f32x4*)(rp + 8 * sub), bq = *(const f32x4*)(rp + 8 * sub + 4);
            kf[0] = a[0]; kf[1] = a[1]; kf[2] = a[2]; kf[3] = a[3]; kf[4] = bq[0]; kf[5] = bq[1]; kf[6] = bq[2]; kf[7] = bq[3];
        } else {
            const u32x4 v = *(const u32x4*)(Hb + (size_t)idx * NINP + HC_K + 8 * sub);
            kf[0] = bf_lo(v.x); kf[1] = bf_hi(v.x); kf[2] = bf_lo(v.y); kf[3] = bf_hi(v.y); kf[4] = bf_lo(v.z); kf[5] = bf_hi(v.z); kf[6] = bf_lo(v.w); kf[7] = bf_hi(v.w);
        }
        f32x4 sv;
#pragma unroll
        for (int hh = 0; hh < 4; ++hh) { float s = 0.f;
#pragma unroll
            for (int d = 0; d < 8; ++d) s = fmaf(qf[hh][d], kf[d], s);
            s += __builtin_bit_cast(float, __builtin_amdgcn_update_dpp(0, __builtin_bit_cast(int, s), 0xB1, 0xF, 0xF, true));
            s += __builtin_bit_cast(float, __builtin_amdgcn_update_dpp(0, __builtin_bit_cast(int, s), 0x4E, 0xF, 0xF, true));
            s += __builtin_bit_cast(float, __builtin_amdgcn_update_dpp(0, __builtin_bit_cast(int, s), 0x141, 0xF, 0xF, true));
            sv[hh] = valid ? s : -INFINITY; }
        if ((sub & 7) == 0) *(LAS f32x4*)(S + ks * 8 + 4 * g) = sv;
    }
    WAVE_SYNC();
    {
        float sv[4][8]; float mx[8];
#pragma unroll
        for (int h = 0; h < 8; ++h) mx[h] = -INFINITY;
#pragma unroll
        for (int m = 0; m < 4; ++m) { const int ks = lane + 64 * m;
            if (ks < nsel) { const f32x4 a = *(LAS const f32x4*)(S + ks * 8), bq = *(LAS const f32x4*)(S + ks * 8 + 4);
                sv[m][0] = a[0]; sv[m][1] = a[1]; sv[m][2] = a[2]; sv[m][3] = a[3]; sv[m][4] = bq[0]; sv[m][5] = bq[1]; sv[m][6] = bq[2]; sv[m][7] = bq[3]; }
            else {
#pragma unroll
                for (int h = 0; h < 8; ++h) sv[m][h] = -INFINITY; }
#pragma unroll
            for (int h = 0; h < 8; ++h) mx[h] = fmaxf(mx[h], sv[m][h]); }
        float sm[8];
#pragma unroll
        for (int h = 0; h < 8; ++h) { mx[h] = wave_max_f(mx[h]); sm[h] = 0.f; }
#pragma unroll
        for (int m = 0; m < 4; ++m) {
#pragma unroll
            for (int h = 0; h < 8; ++h) { sv[m][h] = __builtin_amdgcn_exp2f(sv[m][h] - mx[h]); sm[h] += sv[m][h]; } }
#pragma unroll
        for (int h = 0; h < 8; ++h) sm[h] = wave_sum_f(sm[h]);
        WAVE_SYNC();
#pragma unroll
        for (int m = 0; m < 4; ++m) { const int ks = lane + 64 * m;
            if (ks < nsel) { *(LAS f32x4*)(S + ks * 8) = (f32x4){sv[m][0], sv[m][1], sv[m][2], sv[m][3]}; *(LAS f32x4*)(S + ks * 8 + 4) = (f32x4){sv[m][4], sv[m][5], sv[m][6], sv[m][7]}; } }
        if (lane < 8) { float v = sm[0];
#pragma unroll
            for (int h = 1; h < 8; ++h) v = (lane == h) ? sm[h] : v;
            INV[lane] = 1.0f / v; }
    }
    WAVE_SYNC();
    float o[4][8];
#pragma unroll
    for (int hh = 0; hh < 4; ++hh)
#pragma unroll
        for (int d = 0; d < 8; ++d) o[hh][d] = 0.f;
    for (int i = 0; i < niter; ++i) {
        const int ks = 4 * i + kq; const bool valid = ks < nsel; const int idx = valid ? (int)sel[ks] : 0;
        float vf[8];
        if (SAMPLE) {
            const float* rp = idx < 8192 ? cv_l + ((size_t)pt[idx >> 7] * 128 + (idx & 127)) * 128 : newv + (size_t)(idx - 8192) * 128;
            const f32x4 a = *(const f32x4*)(rp + 8 * sub), bq = *(const f32x4*)(rp + 8 * sub + 4);
            vf[0] = a[0]; vf[1] = a[1]; vf[2] = a[2]; vf[3] = a[3]; vf[4] = bq[0]; vf[5] = bq[1]; vf[6] = bq[2]; vf[7] = bq[3];
        } else {
            const u32x4 v = *(const u32x4*)(Hb + (size_t)idx * NINP + HC_V + 8 * sub);
            vf[0] = bf_lo(v.x); vf[1] = bf_hi(v.x); vf[2] = bf_lo(v.y); vf[3] = bf_hi(v.y); vf[4] = bf_lo(v.z); vf[5] = bf_hi(v.z); vf[6] = bf_lo(v.w); vf[7] = bf_hi(v.w);
        }
        f32x4 p = *(LAS const f32x4*)(S + ks * 8 + 4 * g);
        if (!valid) p = (f32x4){0.f, 0.f, 0.f, 0.f};
#pragma unroll
        for (int hh = 0; hh < 4; ++hh)
#pragma unroll
            for (int d = 0; d < 8; ++d) o[hh][d] = fmaf(p[hh], vf[d], o[hh][d]);
    }
#pragma unroll
    for (int hh = 0; hh < 4; ++hh)
#pragma unroll
        for (int d = 0; d < 8; ++d) { float v = o[hh][d]; v += __shfl_xor(v, 16); v += __shfl_xor(v, 32); o[hh][d] = v; }
    if (kq == 0) {
        const f32x4 iv = *(LAS const f32x4*)(INV + 4 * g);
#pragma unroll
        for (int hh = 0; hh < 4; ++hh) { const float s = iv[hh];
            u32x4 w; w.x = pg8::cvt_pk_bf16(o[hh][0] * s, o[hh][1] * s); w.y = pg8::cvt_pk_bf16(o[hh][2] * s, o[hh][3] * s); w.z = pg8::cvt_pk_bf16(o[hh][4] * s, o[hh][5] * s); w.w = pg8::cvt_pk_bf16(o[hh][6] * s, o[hh][7] * s);
            *(u32x4*)(orow + (4 * g + hh) * 64 + d0) = w; }
    }
    WAVE_SYNC();
}

__device__ __forceinline__ void p2b_prompt_query(LAS unsigned char* wl, const bf16* H, const unsigned* PB, const int* PC, bf16* CAT, int qi, int G, int lane) {
    const int b = qi >> 13, t = qi & 8191, j = t >> 6, ql = t & 63;
    const int base = b * ITEMS_PER_BATCH + j * (j + 1) / 2;
    const int c0 = cu_of_item(base, G), c1 = cu_of_item(base + j, G);
    LAS unsigned* uni = (LAS unsigned*)(wl + W_UNI);
    LAS unsigned* sel = (LAS unsigned*)(wl + W_SEL);
    LAS unsigned* hist = (LAS unsigned*)(wl + W_HIST);
    int n = 0;
    WAVE_SYNC();
    for (int p = 0; p <= c1 - c0 && p < 3; ++p) {
        const size_t slot = (size_t)((b * 128 + j) * 3 + p) * 64 + ql;
        int cp = PC[slot]; cp = cp < 0 ? 0 : (cp > 512 ? 512 : cp);
        const unsigned* src = PB + slot * 512;
        for (int k = lane; k < cp; k += 64) uni[n + k] = src[k];
        n += cp;
    }
    WAVE_SYNC();
    unsigned e[24]; unsigned tau = 0u;
    if (n > 256) tau = wave_select<24>(uni, n, 256, 256, hist, lane, e);
    else {
#pragma unroll
        for (int i = 0; i < 24; ++i) { const int idx = i * 64 + lane; e[i] = idx < n ? uni[idx] : 0u; }
    }
    int nsel = 0;
    WAVE_SYNC();
#pragma unroll
    for (int i = 0; i < 24; ++i) { const int idx = i * 64 + lane; const bool keep = idx < n && e[i] >= tau; const unsigned long long m = __ballot(keep);
        const int pos = nsel + (int)__builtin_amdgcn_mbcnt_hi((unsigned)(m >> 32), __builtin_amdgcn_mbcnt_lo((unsigned)m, 0u)); if (keep && pos < 256) sel[pos] = 8191u - (e[i] & 0x1fffu); nsel += (int)__builtin_popcountll(m); }
    nsel = nsel > 256 ? 256 : nsel;
    const int row = b * SEQ + t;
    attend_query<false>(wl, nsel, H + (size_t)row * NINP, H + (size_t)b * SEQ * NINP, nullptr, nullptr, nullptr, nullptr, nullptr, CAT + (size_t)row * DM + 256, lane);
}

__device__ __forceinline__ void p2b_sample_query(LAS unsigned char* wl, const bf16* H, const unsigned* SS, const float* ck_l, const float* cv_l, const int* page_table,
                                                 const float* newk_l, const float* newv_l, bf16* CAT, int sq, int lane) {
    const int bd = sq >> 2;
    const unsigned* row = SS + (size_t)sq * SS_PITCH;
    LAS unsigned* sel = (LAS unsigned*)(wl + W_SEL);
    LAS unsigned* hist = (LAS unsigned*)(wl + W_HIST);
    constexpr int N = 8196, NP = (N + 63) / 64, K = 256;
    unsigned mn = 0xffffffffu, mx = 0u;
    for (int i = 0; i < NP; ++i) { const int idx = i * 64 + lane; if (idx < N) { const unsigned v = row[idx]; mn = v < mn ? v : mn; mx = v > mx ? v : mx; } }
    unsigned lo = wave_min_u(mn), hi = wave_max_u(mx); int above = 0; unsigned tau = lo;
    for (int iter = 0; iter < 8; ++iter) {
        const unsigned range = hi - lo;
        int s = 26 - (int)__builtin_clz(range | 1u); s = s < 0 ? 0 : s;
        WAVE_SYNC();
        hist[lane] = 0u;
        WAVE_SYNC();
        for (int i = 0; i < NP; ++i) { const int idx = i * 64 + lane; if (idx < N) { const unsigned v = row[idx]; if (v >= lo && v <= hi) __hip_atomic_fetch_add(&hist[(v - lo) >> s], 1u, __ATOMIC_RELAXED, __HIP_MEMORY_SCOPE_WORKGROUP); } }
        WAVE_SYNC();
        unsigned S = hist[lane];
#pragma unroll
        for (int d = 1; d < 64; d <<= 1) { const unsigned y = (unsigned)__shfl_down((int)S, d); if (lane + d < 64) S += y; }
        const int Kc = K - above;
        const unsigned long long m = __ballot((int)S >= Kc);
        const int bs = m ? 63 - (int)__builtin_clzll(m) : 0;
        const unsigned Sb = (unsigned)__shfl((int)S, bs), Sb1 = bs < 63 ? (unsigned)__shfl((int)S, bs + 1) : 0u;
        const unsigned edge = lo + ((unsigned)bs << s);
        tau = edge;
        if (above + (int)Sb <= K || s == 0) break;
        above += (int)Sb1; lo = edge;
        const unsigned w1 = (1u << s) - 1u; const unsigned nh = (edge > 0xffffffffu - w1) ? 0xffffffffu : edge + w1; hi = nh < hi ? nh : hi;
    }
    int nsel = 0;
    WAVE_SYNC();
    for (int i = 0; i < NP; ++i) { const int idx = i * 64 + lane; unsigned v = 0u; bool keep = false; if (idx < N) { v = row[idx]; keep = v >= tau; }
        const unsigned long long m = __ballot(keep);
        const int pos = nsel + (int)__builtin_amdgcn_mbcnt_hi((unsigned)(m >> 32), __builtin_amdgcn_mbcnt_lo((unsigned)m, 0u)); if (keep && pos < 256) sel[pos] = 16383u - (v & 0x3fffu); nsel += (int)__builtin_popcountll(m); }
    nsel = nsel > 256 ? 256 : nsel;
    const int rowi = MP + sq;
    attend_query<true>(wl, nsel, H + (size_t)rowi * NINP, nullptr, ck_l, cv_l, page_table + bd * NPAGES, newk_l + (size_t)bd * 4 * 128, newv_l + (size_t)bd * 4 * 128, CAT + (size_t)rowi * DM + 256, lane);
}

__device__ __forceinline__ void p2b_mixA_item(const bf16* H, const float* conv_a_l, const float* state_conv_l, bf16* CAT, float* out, int layer, int item, int lane) {
    const int r0 = item * 16;
    const int ch = 4 * lane;
    const f32x4 w0 = *(const f32x4*)(conv_a_l + ch), w1 = *(const f32x4*)(conv_a_l + 256 + ch), w2 = *(const f32x4*)(conv_a_l + 512 + ch);
    f32x4 y2 = (f32x4){0.f, 0.f, 0.f, 0.f}, y1 = y2;
    const bool sample = r0 >= MP;
    if (!sample) { const int t0 = r0 & 8191;
        if (t0 >= 2) { const bf16* p = H + (size_t)(r0 - 2) * NINP; y2 = ld4bf(p + HC_GC + ch) * ld4bf(p + HC_HA + ch); p += NINP; y1 = ld4bf(p + HC_GC + ch) * ld4bf(p + HC_HA + ch); } }
    for (int i = 0; i < 16; ++i) {
        const int r = r0 + i;
        if (sample && ((r - MP) & 3) == 0) { const int bd = (r - MP) >> 2; y2 = *(const f32x4*)(state_conv_l + (size_t)bd * 512 + ch); y1 = *(const f32x4*)(state_conv_l + (size_t)bd * 512 + 256 + ch); }
        const bf16* p = H + (size_t)r * NINP;
        const f32x4 y0 = ld4bf(p + HC_GC + ch) * ld4bf(p + HC_HA + ch);
        const f32x4 a = ld4bf(p + HC_GB + ch) * (w0 * y2 + w1 * y1 + w2 * y0);
        u32x2 w; w.x = pg8::cvt_pk_bf16(a[0], a[1]); w.y = pg8::cvt_pk_bf16(a[2], a[3]);
        *(u32x2*)(CAT + (size_t)r * DM + ch) = w;
        if (!sample) { const int t = r & 8191; if (t >= 8190) *(f32x4*)(out + OFF_CP + ((size_t)(layer * NB + (r >> 13)) * 2 + (t - 8190)) * 256 + ch) = y0; }
        else { const int ts = (r - MP) & 3, bd = (r - MP) >> 2; if (ts >= 2) *(f32x4*)(out + OFF_CS + ((size_t)(layer * DB + bd) * 2 + (ts - 2)) * 256 + ch) = y0; }
        y2 = y1; y1 = y0;
    }
}

__device__ __forceinline__ void p2b_mixC_sample(const bf16* H, const float* g_l, const float* b_l, const float* wsp_l, const float* bsp_l, bf16* CAT, float* out, int layer, int bd, int lane) {
    const int ch = 4 * lane, h = ch >> 6;
    const f32x4 gg = *(const f32x4*)(g_l + ch), bb = *(const f32x4*)(b_l + ch);
    f32x4 vn[4];
#pragma unroll
    for (int ts = 0; ts < 4; ++ts) { const bf16* p = H + (size_t)(MP + 4 * bd + ts) * NINP + HC_VC + ch; const u32x2 v = *(const u32x2*)p;
        f32x4 x = (f32x4){bf_lo(v.x), bf_hi(v.x), bf_lo(v.y), bf_hi(v.y)};
        const float mu = wave_sum_f((x[0] + x[1]) + (x[2] + x[3])) * (1.f / 256.f); x = x - mu;
        const float var = wave_sum_f((x[0] * x[0] + x[1] * x[1]) + (x[2] * x[2] + x[3] * x[3])) * (1.f / 256.f);
        vn[ts] = x * (1.0f / sqrtf(var + LN_EPS)) * gg + bb;
        *(f32x4*)(out + OFF_CH + ((size_t)(layer * DB + bd) * 4 + ts) * 256 + ch) = vn[ts]; }
#pragma unroll
    for (int ts = 0; ts < 4; ++ts) { f32x4 mix = (f32x4){0.f, 0.f, 0.f, 0.f};
#pragma unroll
        for (int s = 0; s <= ts; ++s) mix = mix + vn[s] * wsp_l[(size_t)(h * 128 + ts) * 128 + s];
        mix = mix + bsp_l[h * 128 + ts];
        const bf16* p = H + (size_t)(MP + 4 * bd + ts) * NINP + HC_U + ch; const u32x2 v = *(const u32x2*)p;
        const f32x4 uu = (f32x4){bf_lo(v.x), bf_hi(v.x), bf_lo(v.y), bf_hi(v.y)};
        const f32x4 o = uu * mix; u32x2 w; w.x = pg8::cvt_pk_bf16(o[0], o[1]); w.y = pg8::cvt_pk_bf16(o[2], o[3]);
        *(u32x2*)(CAT + (size_t)(MP + 4 * bd + ts) * DM + 768 + ch) = w; }
}

constexpr int VT_PITCH = 272;
__device__ __forceinline__ void p2b_mixC_chunk(LAS unsigned char* lds, const bf16* H, const float* g_l, const float* b_l, const bf16* wtril_l, const float* bsp_l, bf16* CAT, int chunk, int tid, int wid, int lane) {
    const int row0 = chunk * 128;
    __syncthreads();
    { const int ch = 4 * lane; const f32x4 gg = *(const f32x4*)(g_l + ch), bb = *(const f32x4*)(b_l + ch);
      for (int i = 0; i < 16; ++i) { const int s = 16 * wid + i; const bf16* p = H + (size_t)(row0 + s) * NINP + HC_VC + ch; const u32x2 v = *(const u32x2*)p;
          f32x4 x = (f32x4){bf_lo(v.x), bf_hi(v.x), bf_lo(v.y), bf_hi(v.y)};
          const float mu = wave_sum_f((x[0] + x[1]) + (x[2] + x[3])) * (1.f / 256.f); x = x - mu;
          const float var = wave_sum_f((x[0] * x[0] + x[1] * x[1]) + (x[2] * x[2] + x[3] * x[3])) * (1.f / 256.f);
          x = x * (1.0f / sqrtf(var + LN_EPS)) * gg + bb;
#pragma unroll
          for (int k = 0; k < 4; ++k) *(LAS bf16*)(lds + (ch + k) * VT_PITCH + s * 2) = (bf16)(pg8::cvt_pk_bf16(x[k], 0.f) & 0xffffu); } }
    __syncthreads();
    const int h = wid >> 1, rh = wid & 1, c = lane & 31, hi = lane >> 5;
    f32x16 acc[2][2];
#pragma unroll
    for (int mt = 0; mt < 2; ++mt)
#pragma unroll
        for (int nt = 0; nt < 2; ++nt)
#pragma unroll
            for (int r = 0; r < 16; ++r) acc[mt][nt][r] = 0.f;
    const bf16* wa = wtril_l + (size_t)(h * 128 + 64 * rh + c) * 128 + hi * 8;
    const int nks = rh == 0 ? 4 : 8;
    for (int ks = 0; ks < nks; ++ks) {
        bf16x8 a[2], bq[2];
#pragma unroll
        for (int mt = 0; mt < 2; ++mt) a[mt] = *(const bf16x8*)(wa + (size_t)(32 * mt) * 128 + ks * 16);
#pragma unroll
        for (int nt = 0; nt < 2; ++nt) bq[nt] = *(const LAS bf16x8*)(lds + (h * 64 + 32 * nt + c) * VT_PITCH + (ks * 16 + hi * 8) * 2);
#pragma unroll
        for (int mt = 0; mt < 2; ++mt)
#pragma unroll
            for (int nt = 0; nt < 2; ++nt) acc[mt][nt] = __builtin_amdgcn_mfma_f32_32x32x16_bf16(a[mt], bq[nt], acc[mt][nt], 0, 0, 0);
    }
#pragma unroll
    for (int mt = 0; mt < 2; ++mt)
#pragma unroll
        for (int r = 0; r < 16; ++r) { const int tt = 64 * rh + 32 * mt + (r & 3) + 8 * (r >> 2) + 4 * hi; const float bsv = bsp_l[h * 128 + tt];
#pragma unroll
            for (int nt = 0; nt < 2; ++nt) { const int col = h * 64 + 32 * nt + c; const float uu = bf_lo((unsigned)H[(size_t)(row0 + tt) * NINP + HC_U + col]);
                const float o = uu * (acc[mt][nt][r] + bsv);
                CAT[(size_t)(row0 + tt) * DM + 768 + col] = (bf16)(pg8::cvt_pk_bf16(o, 0.f) & 0xffffu); } }
    __syncthreads();
}

__device__ __forceinline__ void p0_transpose_item(const float* W, int K, int N, bf16* WT, int shift_from, int shift, LAS float* scr, int item, int lane) {
    const int nblk = (N + 31) / 32, kb = item / nblk, nb = item % nblk, k0 = 64 * kb, n0 = 32 * nb;
    const int nn = n0 + (lane & 31);
#pragma unroll 8
    for (int i = 0; i < 32; ++i) { const int kk = 2 * i + (lane >> 5); scr[kk * 33 + (lane & 31)] = nn < N ? W[(size_t)(k0 + kk) * N + nn] : 0.f; }
    LDS_WAIT(); asm volatile("" ::: "memory");
    const int c = lane & 7;
#pragma unroll
    for (int jx = 0; jx < 4; ++jx) { const int n = (lane >> 3) + 8 * jx; const LAS float* s = scr + (8 * c) * 33 + n;
        v4u o; o.x = pk2(s[0 * 33], s[1 * 33]); o.y = pk2(s[2 * 33], s[3 * 33]); o.z = pk2(s[4 * 33], s[5 * 33]); o.w = pk2(s[6 * 33], s[7 * 33]);
        const int ns = n0 + n; if (ns < N) { const int nd = ns + (ns >= shift_from ? shift : 0); *(GAS v4u*)(WT + (size_t)nd * K + k0 + 8 * c) = o; } }
    LDS_WAIT(); asm volatile("" ::: "memory");
}
struct KArgs { const float* in[22]; float* out; unsigned char* ws; int ph_lo, ph_hi, li, pad; };
__device__ __forceinline__ void sincos_d(double x, double& sn, double& cs) {
    const double k = __builtin_rint(x * 0.6366197723675814);
    double r = __builtin_fma(-k, 1.5707963267948966, x); r = __builtin_fma(-k, 6.123233995736766e-17, r);
    const double r2 = r * r;
    double sp = 1.0 / 6227020800.0; sp = sp * r2 - 1.0 / 39916800.0; sp = sp * r2 + 1.0 / 362880.0; sp = sp * r2 - 1.0 / 5040.0; sp = sp * r2 + 1.0 / 120.0; sp = sp * r2 - 1.0 / 6.0; sp = sp * r2 * r + r;
    double cp = -1.0 / 87178291200.0; cp = cp * r2 + 1.0 / 479001600.0; cp = cp * r2 - 1.0 / 3628800.0; cp = cp * r2 + 1.0 / 40320.0; cp = cp * r2 - 1.0 / 720.0; cp = cp * r2 + 1.0 / 24.0; cp = cp * r2 - 0.5; cp = cp * r2 + 1.0;
    const int q = (int)((long long)k & 3);
    sn = (q == 0) ? sp : (q == 1) ? cp : (q == 2) ? -sp : -cp;
    cs = (q == 0) ? cp : (q == 1) ? -sp : (q == 2) ? -cp : sp;
}

__device__ __forceinline__ void p0_prologue(const KArgs& a, LAS unsigned char* lds, int vcu, int G, int tid, int wid, int lane) {
    unsigned char* ws = a.ws;
    LAS float* scr = (LAS float*)(lds + wid * 16384);
    const int gw = vcu * NWAVES + wid, NGW = G * NWAVES;
    const long gt = (long)gw * 64 + lane, NGT = (long)NGW * 64;
    constexpr int I_IN = (DM / 64) * ((NIN + 31) / 32), I_O = (DM / 64) * (DM / 32), I_UP = (DM / 64) * (NUP / 32), I_DN = (DFF / 64) * (DM / 32), I_L = I_IN + I_O + I_UP + I_DN;
    for (int it = gw; it < DEPTH * I_L; it += NGW) {
        const int l = it / I_L; int r = it % I_L;
        if (r < I_IN) { p0_transpose_item(a.in[8] + (size_t)l * DM * NIN, DM, NIN, (bf16*)(ws + WS_WIN) + (size_t)l * NINP * DM, 2120, 184, scr, r, lane); continue; } r -= I_IN;
        if (r < I_O) { p0_transpose_item(a.in[14] + (size_t)l * DM * DM, DM, DM, (bf16*)(ws + WS_WO) + (size_t)l * DM * DM, 1 << 30, 0, scr, r, lane); continue; } r -= I_O;
        if (r < I_UP) { p0_transpose_item(a.in[17] + (size_t)l * DM * NUP, DM, NUP, (bf16*)(ws + WS_WUP) + (size_t)l * NUP * DM, 1 << 30, 0, scr, r, lane); continue; } r -= I_UP;
        p0_transpose_item(a.in[19] + (size_t)l * DFF * DM, DFF, DM, (bf16*)(ws + WS_WDN) + (size_t)l * DM * DFF, 1 << 30, 0, scr, r, lane);
    }
    { constexpr long PER = 184L * DM / 8;
      for (long i = gt; i < DEPTH * PER; i += NGT) { const int l = (int)(i / PER); const long o = i % PER; *(v4u*)((bf16*)(ws + WS_WIN) + ((size_t)l * NINP + 2120) * DM + o * 8) = (v4u){0u, 0u, 0u, 0u}; } }
    { const float* wsp = a.in[12]; bf16* wt = (bf16*)(ws + WS_WTRIL);
      for (long i = gt; i < (long)DEPTH * 4 * 128 * 128; i += NGT) { const int s = (int)(i & 127), t = (int)((i >> 7) & 127); wt[i] = (bf16)(s <= t ? f2bf(wsp[i]) : 0u); } }
    { float* rope = (float*)(ws + WS_ROPE);
      for (long i = gt; i < 8200L * 8; i += NGT) { const int pos = (int)(i >> 3), jx = (int)(i & 7);
          const double inv = jx == 0 ? 1.0 : jx == 1 ? 0.19392274474868576 : jx == 2 ? 0.03760603093086393 : jx == 3 ? 0.007292664737217109 : jx == 4 ? 0.001414213562373095
                           : jx == 5 ? 0.0002742481756762073 : jx == 6 ? 5.318295896944988e-05 : 1.031338537721246e-05;
          double sn, cs; sincos_d((double)pos * inv, sn, cs);
          rope[(size_t)pos * 16 + jx] = (float)cs; rope[(size_t)pos * 16 + 8 + jx] = (float)sn; } }
    { float* X = (float*)(ws + WS_X); bf16* XB = (bf16*)(ws + WS_XB);
      for (long i = gt; i < (long)MPAD * DM / 4; i += NGT) { const long row = i >> 8; const int c4 = (int)(i & 255) * 4;
          f32x4 v = (f32x4){0.f, 0.f, 0.f, 0.f};
          if (row < MP) v = *(const f32x4*)(a.in[0] + row * DM + c4); else if (row < MR) v = *(const f32x4*)(a.in[1] + (row - MP) * DM + c4);
          *(f32x4*)(X + row * DM + c4) = v; u32x2 w; w.x = pk2(v[0], v[1]); w.y = pk2(v[2], v[3]); *(u32x2*)(XB + row * DM + c4) = w; } }
}

__device__ __forceinline__ void ln_phase(const float* Y, const float* gam, const float* bet, float* X, bf16* XB, float* outp, float* outs, int gw, int NGW, int lane) {
    f32x4 gg[4], bb[4];
#pragma unroll
    for (int jx = 0; jx < 4; ++jx) { gg[jx] = *(const f32x4*)(gam + 4 * lane + 256 * jx); bb[jx] = *(const f32x4*)(bet + 4 * lane + 256 * jx); }
    for (int m = gw; m < MR; m += NGW) {
        const f32x4* yr = (const f32x4*)(Y + (size_t)m * DM) + lane;
        f32x4 v[4]; float s = 0.f;
#pragma unroll
        for (int jx = 0; jx < 4; ++jx) { v[jx] = yr[64 * jx]; s += (v[jx][0] + v[jx][1]) + (v[jx][2] + v[jx][3]); }
        const float mean = wave_sum_f(s) * (1.f / DM); float s2 = 0.f;
#pragma unroll
        for (int jx = 0; jx < 4; ++jx) { v[jx] = v[jx] - mean; s2 += (v[jx][0] * v[jx][0] + v[jx][1] * v[jx][1]) + (v[jx][2] * v[jx][2] + v[jx][3] * v[jx][3]); }
        const float rstd = 1.f / sqrtf(wave_sum_f(s2) * (1.f / DM) + LN_EPS);
        float* od = nullptr; if (outp) od = m < MP ? outp + (size_t)m * DM : outs + (size_t)(m - MP) * DM;
#pragma unroll
        for (int jx = 0; jx < 4; ++jx) { const f32x4 o = v[jx] * rstd * gg[jx] + bb[jx];
            *((f32x4*)(X + (size_t)m * DM) + lane + 64 * jx) = o;
            u32x2 w; w.x = pk2(o[0], o[1]); w.y = pk2(o[2], o[3]); *((u32x2*)(XB + (size_t)m * DM) + lane + 64 * jx) = w;
            if (od) *((f32x4*)od + lane + 64 * jx) = o; }
    }
}

__device__ __forceinline__ void convgate_item(const bf16* Z, const float* cf_l, const float* state_l, bf16* A2, float* out, int layer, int item, int lane) {
    const int rb = item / 11, cb = item % 11;
    const int r0 = rb * 16, ch = cb * 256 + 4 * lane;
    const f32x4 g0 = *(const f32x4*)(cf_l + ch), g1 = *(const f32x4*)(cf_l + NUP + ch), g2 = *(const f32x4*)(cf_l + 2 * NUP + ch);
    const f32x4 u0 = *(const f32x4*)(cf_l + DFF + ch), u1 = *(const f32x4*)(cf_l + NUP + DFF + ch), u2 = *(const f32x4*)(cf_l + 2 * NUP + DFF + ch);
    f32x4 zg2 = (f32x4){0.f, 0.f, 0.f, 0.f}, zg1 = zg2, zu2 = zg2, zu1 = zg2;
    const bool sample = r0 >= MP;
    if (!sample && (r0 & 8191) >= 2) { const bf16* p = Z + (size_t)(r0 - 2) * NUP; zg2 = ld4bf(p + ch); zu2 = ld4bf(p + DFF + ch); p += NUP; zg1 = ld4bf(p + ch); zu1 = ld4bf(p + DFF + ch); }
    for (int i = 0; i < 16; ++i) {
        const int r = r0 + i;
        if (sample && ((r - MP) & 3) == 0) { const float* sp = state_l + (size_t)((r - MP) >> 2) * 2 * NUP;
            zg2 = *(const f32x4*)(sp + ch); zu2 = *(const f32x4*)(sp + DFF + ch); zg1 = *(const f32x4*)(sp + NUP + ch); zu1 = *(const f32x4*)(sp + NUP + DFF + ch); }
        const bf16* p = Z + (size_t)r * NUP;
        const f32x4 zg0 = ld4bf(p + ch), zu0 = ld4bf(p + DFF + ch);
        const f32x4 hg = g0 * zg2 + g1 * zg1 + g2 * zg0, hu = u0 * zu2 + u1 * zu1 + u2 * zu0;
        f32x4 o;
#pragma unroll
        for (int k = 0; k < 4; ++k) o[k] = hg[k] / (1.f + __expf(-hg[k])) * hu[k];
        u32x2 w; w.x = pg8::cvt_pk_bf16(o[0], o[1]); w.y = pg8::cvt_pk_bf16(o[2], o[3]);
        *(u32x2*)(A2 + (size_t)r * DFF + ch) = w;
        int oi = -1; size_t obase = 0;
        if (!sample) { const int t = r & 8191; if (t >= 8190) { oi = t - 8190; obase = OFF_FP + ((size_t)(layer * NB + (r >> 13)) * 2 + oi) * NUP; } }
        else { const int ts = (r - MP) & 3; if (ts >= 2) { oi = ts - 2; obase = OFF_FS + ((size_t)(layer * DB + ((r - MP) >> 2)) * 2 + oi) * NUP; } }
        if (oi >= 0) { *(f32x4*)(out + obase + ch) = zg0; *(f32x4*)(out + obase + DFF + ch) = zu0; }
        zg2 = zg1; zg1 = zg0; zu2 = zu1; zu1 = zu0;
    }
}

#ifndef MK_PER_PHASE
#define MK_PER_PHASE 0
#endif
#ifndef MK_LAST_PHASE
#define MK_LAST_PHASE 37
#endif
constexpr int NPHASES = 1 + 9 * DEPTH;
#ifndef MK_MASK
#define MK_MASK 0x3ff
#endif
#define PM(k) ((MK_MASK >> (k)) & 1)
__global__ void __launch_bounds__(NWAVES * 64, 2) fwd_kernel(KArgs a) {
    extern __shared__ __attribute__((aligned(16))) unsigned char lds_raw[];
    LAS unsigned char* lds = (LAS unsigned char*)lds_raw;
    const int wid = __builtin_amdgcn_readfirstlane((int)threadIdx.x >> 6);
    gu32* ctl = (gu32*)(a.ws + WS_CTL);
    volatile LAS unsigned* MISC = (volatile LAS unsigned*)(lds + MISC_OFF);
    if (threadIdx.x < 64) MISC[threadIdx.x] = 0u;
    __syncthreads();
    XcdBarrier bar = xcd_barrier_post((unsigned*)(ctl + CW_BAR) + a.li * XCD_BAR_WORDS, MISC + 8);
    const int lo = a.ph_lo, hi = a.ph_hi;
#define IN(k) (lo <= (k) && (k) < hi)
#define SEAM(k) do { if (IN(k) && IN((k) + 1)) xcd_barrier(bar); } while (0)
#define WSP(T, off) ((T)(wsl + (off)))
#define PHASE_LOCALS() unsigned char* wsl = a.ws; asm volatile("" : "+s"(wsl)); int lane_ = (int)__builtin_amdgcn_mbcnt_hi(~0u, __builtin_amdgcn_mbcnt_lo(~0u, 0u)); asm volatile("" : "+v"(lane_)); const int lane = lane_; const int tid = wid * 64 + lane; (void)tid; (void)lane; \
    int G_ = gridDim.x, bx_ = blockIdx.x; asm volatile("" : "+s"(G_), "+s"(bx_)); const int G = G_, bx = bx_; const int vcu = (G % 8 == 0) ? (bx % 8) * (G / 8) + bx / 8 : bx; const int gw = vcu * NWAVES + wid, NGW = G * NWAVES; (void)gw; (void)NGW; (void)vcu; (void)bx;
    if (PM(0) && IN(0)) { PHASE_LOCALS(); p0_prologue(a, lds, vcu, G, tid, wid, lane); }
    SEAM(0);
#pragma unroll 1
    for (int l = 0; l < DEPTH; ++l) {
        const int pb = 1 + 9 * l;
        if (PM(1) && IN(pb)) {
            PHASE_LOCALS();
            pg8::Gemm g{WSP(bf16*, WS_XB), WSP(bf16*, WS_WIN) + (size_t)l * NINP * DM, MPAD, NINP, DM}; pg8::StaticOrder S; S.init(MPAD, NINP, G, bx);
            pg8::EpiInProj E{WSP(bf16*, WS_H), WSP(float*, WS_WI), a.out, WSP(const float*, WS_ROPE), l, OFF_KP, OFF_KS, OFF_VP, OFF_VS, OFF_KIP, OFF_KIS};
            pg8::gemm_phase<pg8::EpiInProj, pg8::StaticOrder, true, true>(lds, g, S, E);
        }
        SEAM(pb);
        if (PM(2) && IN(pb + 1)) {
            PHASE_LOCALS();
            bf16* H = WSP(bf16*, WS_H); float* WI = WSP(float*, WS_WI);
            p2a_prompt(lds, H, WI, WSP(unsigned*, WS_PB), WSP(int*, WS_PC), vcu, G, tid, wid, lane);
            __syncthreads();
            const float* ckidx_l = a.in[4] + (size_t)l * NPOOL * 128 * 64;
            for (int u = gw; u < DB * NPAGES; u += NGW) p2a_sample_unit(H, WI, ckidx_l, (const int*)a.in[5], WSP(unsigned*, WS_SS), u >> 6, u & 63, lane);
        }
        SEAM(pb + 1);
        if (PM(3) && IN(pb + 2)) {
            PHASE_LOCALS();
            bf16* H = WSP(bf16*, WS_H); bf16* CAT = WSP(bf16*, WS_CAT); const bf16* WTRIL = WSP(const bf16*, WS_WTRIL); unsigned* PB = WSP(unsigned*, WS_PB); int* PC = WSP(int*, WS_PC); unsigned* SS = WSP(unsigned*, WS_SS);
            const int* page_table = (const int*)a.in[5];
            const float* lg = a.in[10] + (size_t)l * 256; const float* lb = a.in[11] + (size_t)l * 256;
            const float* bsp_l = a.in[13] + (size_t)l * 4 * 128;
            for (int ck = vcu; ck < MP / 128; ck += G) p2b_mixC_chunk(lds, H, lg, lb, WTRIL + (size_t)l * 4 * 128 * 128, bsp_l, CAT, ck, tid, wid, lane);
            __syncthreads();
            LAS unsigned char* wl = lds + wid * 16384;
            const float* ck_l = a.in[2] + (size_t)l * NPOOL * 128 * 128; const float* cv_l = a.in[3] + (size_t)l * NPOOL * 128 * 128;
            for (int sq = gw; sq < MS; sq += NGW) p2b_sample_query(wl, H, SS, ck_l, cv_l, page_table, a.out + OFF_KS + (size_t)l * MS * 128, a.out + OFF_VS + (size_t)l * MS * 128, CAT, sq, lane);
            for (int q = gw; q < MP; q += NGW) p2b_prompt_query(wl, H, PB, PC, CAT, q, G, lane);
            for (int it = gw; it < MR / 16; it += NGW) p2b_mixA_item(H, a.in[9] + (size_t)l * 3 * 256, a.in[6] + (size_t)l * DB * 2 * 256, CAT, a.out, l, it, lane);
            for (int bd = gw; bd < DB; bd += NGW) p2b_mixC_sample(H, lg, lb, a.in[12] + (size_t)l * 4 * 128 * 128, bsp_l, CAT, a.out, l, bd, lane);
        }
        SEAM(pb + 2);
        if (PM(4) && IN(pb + 3)) {
            PHASE_LOCALS();
            pg8::Gemm g{WSP(bf16*, WS_CAT), WSP(bf16*, WS_WO) + (size_t)l * DM * DM, MPAD, DM, DM}; pg8::StaticOrder S; S.init(MPAD, DM, G, bx);
            pg8::EpiResF32 E{WSP(float*, WS_X), WSP(float*, WS_Y), ALPHA};
            pg8::gemm_phase<pg8::EpiResF32, pg8::StaticOrder, true, true>(lds, g, S, E);
        }
        SEAM(pb + 3);
        if (PM(5) && IN(pb + 4)) { PHASE_LOCALS(); ln_phase(WSP(float*, WS_Y), a.in[15] + (size_t)l * DM, a.in[16] + (size_t)l * DM, WSP(float*, WS_X), WSP(bf16*, WS_XB), nullptr, nullptr, gw, NGW, lane); }
        SEAM(pb + 4);
        if (PM(6) && IN(pb + 5)) {
            PHASE_LOCALS();
            pg8::Gemm g{WSP(bf16*, WS_XB), WSP(bf16*, WS_WUP) + (size_t)l * NUP * DM, MPAD, NUP, DM}; pg8::StaticOrder S; S.init(MPAD, NUP, G, bx);
            pg8::EpiPlainBf16 E{WSP(bf16*, WS_Z), NUP};
            pg8::gemm_phase<pg8::EpiPlainBf16, pg8::StaticOrder, true, true>(lds, g, S, E);
        }
        SEAM(pb + 5);
        if (PM(7) && IN(pb + 6)) { PHASE_LOCALS(); for (int it = gw; it < (MR / 16) * 11; it += NGW) convgate_item(WSP(bf16*, WS_Z), a.in[18] + (size_t)l * 3 * NUP, a.in[7] + (size_t)l * DB * 2 * NUP, WSP(bf16*, WS_A2), a.out, l, it, lane); }
        SEAM(pb + 6);
        if (PM(8) && IN(pb + 7)) {
            PHASE_LOCALS();
            pg8::Gemm g{WSP(bf16*, WS_A2), WSP(bf16*, WS_WDN) + (size_t)l * DM * DFF, MPAD, DM, DFF}; pg8::StaticOrder S; S.init(MPAD, DM, G, bx);
            pg8::EpiResF32 E{WSP(float*, WS_X), WSP(float*, WS_Y), ALPHA};
            pg8::gemm_phase<pg8::EpiResF32, pg8::StaticOrder, true, true>(lds, g, S, E);
        }
        SEAM(pb + 7);
        if (PM(9) && IN(pb + 8)) { PHASE_LOCALS(); const bool last = (l == DEPTH - 1);
            ln_phase(WSP(float*, WS_Y), a.in[20] + (size_t)l * DM, a.in[21] + (size_t)l * DM, WSP(float*, WS_X), WSP(bf16*, WS_XB), last ? a.out + OFF_YP : nullptr, last ? a.out + OFF_YS : nullptr, gw, NGW, lane); }
        SEAM(pb + 8);
    }
#undef IN
#undef SEAM
}

extern "C" void kernel_launch(void* const* d_in, const int* in_sizes, int n_in, void* d_out, int out_size, void* d_ws, size_t ws_size, hipStream_t stream) {
    static int grid = 0;
    if (grid == 0) {
        if (n_in != 22 || (size_t)out_size != OUT_TOTAL || ws_size < WS_END) { fprintf(stderr, "kernel_launch: unexpected shapes (n_in %d, out %d, ws %zu)\n", n_in, out_size, ws_size); grid = -1; return; }
        int dev = 0, cus = 0, per_cu = 0;
        if (hipGetDevice(&dev) != hipSuccess || hipDeviceGetAttribute(&cus, hipDeviceAttributeMultiprocessorCount, dev) != hipSuccess) { grid = -1; return; }
        if (hipFuncSetAttribute((const void*)fwd_kernel, hipFuncAttributeMaxDynamicSharedMemorySize, LDS_BYTES) != hipSuccess) { fprintf(stderr, "kernel_launch: hipFuncSetAttribute failed\n"); grid = -1; return; }
        if (hipOccupancyMaxActiveBlocksPerMultiprocessor(&per_cu, (const void*)fwd_kernel, NWAVES * 64, LDS_BYTES) != hipSuccess || per_cu < 1) fprintf(stderr, "kernel_launch: occupancy query reports %d\n", per_cu);
        (void)hipGetLastError();
        grid = cus;
    }
    if (grid < 0) return;
    if (hipMemsetAsync((char*)d_ws + WS_CTL, 0, CTL_ZERO_BYTES, stream) != hipSuccess) return;
    KArgs a{};
    for (int i = 0; i < 22; ++i) a.in[i] = (const float*)d_in[i];
    a.out = (float*)d_out; a.ws = (unsigned char*)d_ws;
#if MK_PER_PHASE
    for (int k = 0; k < MK_LAST_PHASE && k < NPHASES; ++k) { a.ph_lo = k; a.ph_hi = k + 1; a.li = 0; a.pad = 0; hipLaunchKernelGGL(fwd_kernel, dim3(grid), dim3(NWAVES * 64), LDS_BYTES, stream, a); }
#else
    a.ph_lo = 0; a.ph_hi = MK_LAST_PHASE < NPHASES ? MK_LAST_PHASE : NPHASES; a.li = 0; a.pad = 0;
    hipLaunchKernelGGL(fwd_kernel, dim3(grid), dim3(NWAVES * 64), LDS_BYTES, stream, a);
#endif
    const hipError_t le = hipPeekAtLastError();
    if (le != hipSuccess) fprintf(stderr, "kernel_launch: launch failed: %s\n", hipGetErrorName(le));
}
```
